# Optimizing an MI355X kernel written in HIP

```python
import math
import jax, jax.numpy as jnp
from jax import lax
import numpy as np

D_MODEL = 2048
BATCH = 16
SEQ = 256
DEPTH = 2
DEC_BATCH = 8
DEC_SEQ = 4096
PAST_LEN = 512

GRID_W = 64
N_MIXERS = 2
N_HGRN = (DEPTH + 1) // 2
N_ATTN = DEPTH // 2
HGRN_EXPAND = 128
HGRN_HEADS = D_MODEL // HGRN_EXPAND
HGRN_DK = HGRN_EXPAND
HGRN_DV = D_MODEL // HGRN_HEADS
CHUNK = 64
DIFF_HEADS = 8
DIFF_HD = D_MODEL // DIFF_HEADS // 2
D_FF = 5632
CONV_W = 3
Q_BLOCK = 128
ROPE_BASE = 10000.0
EPS = 1e-6
F32 = jnp.float32

kernel_name = 'hybrid_hgrn2_diffattn_diffusion_step'


def rmsnorm(x, g):
    x32 = x.astype(F32)
    y = x32 * lax.rsqrt(jnp.mean(x32 * x32, axis=-1, keepdims=True) + EPS)
    return (y * g.astype(F32)).astype(x.dtype)


def ada_mod(cvec, w, b):
    m = jax.nn.silu(cvec) @ w + b
    return jnp.split(m[:, None, :], 6, axis=-1)


def modulate(h, shift, scale):
    return h * (1 + scale) + shift


def axial_rope(L, hd):
    rows = L // GRID_W
    row = jnp.repeat(jnp.arange(rows), GRID_W).astype(F32)
    col = jnp.tile(jnp.arange(GRID_W), rows).astype(F32)
    nf = hd // 4
    inv = ROPE_BASE ** (-jnp.arange(nf, dtype=F32) / nf)
    ang = jnp.stack([row[:, None] * inv, col[:, None] * inv], axis=1)
    return jnp.cos(ang), jnp.sin(ang)


def apply_axial_rope(x, cos, sin):
    B, L, H, hd = x.shape
    nf = hd // 4
    xr = x.astype(F32).reshape(B, L, H, 2, 2, nf)
    x1, x2 = xr[..., 0, :], xr[..., 1, :]
    c = cos[None, :, None]
    s = sin[None, :, None]
    out = jnp.stack([x1 * c - x2 * s, x2 * c + x1 * s], axis=-2)
    return out.reshape(B, L, H, hd).astype(x.dtype)


def chunk_scan(q, k, v, log_f, s0):
    B, L, H, _ = q.shape
    DV = v.shape[-1]
    n = L // CHUNK
    to_chunks = lambda t: t.reshape(B, n, CHUNK, H, t.shape[-1]).transpose(1, 0, 3, 2, 4)
    causal = jnp.tril(jnp.ones((CHUNK, CHUNK), bool))

    def step(S, inp):
        qc, kc, vc, gc = inp
        b = jnp.cumsum(gc, axis=2)
        inter = jnp.einsum('bhtk,bhkv->bhtv', qc * jnp.exp(b), S)
        diff = b[:, :, :, None, :] - b[:, :, None, :, :]
        decay = jnp.exp(jnp.where(causal[:, :, None], diff, -jnp.inf))
        scores = jnp.einsum('bhtk,bhsk,bhtsk->bhts', qc, kc, decay)
        intra = jnp.einsum('bhts,bhsv->bhtv', scores, vc)
        b_last = b[:, :, -1:, :]
        S_new = jnp.exp(b_last[:, :, 0, :])[..., None] * S + jnp.einsum('bhsk,bhsv->bhkv', kc * jnp.exp(b_last - b), vc)
        return S_new, inter + intra

    S_fin, o = lax.scan(step, s0, (to_chunks(q), to_chunks(k), to_chunks(v), to_chunks(log_f)))
    o = o.transpose(1, 0, 3, 2, 4).reshape(B, L, H, DV)
    return o, S_fin


def hgrn_direction(q, z, v, lb, s0):
    f = lb + (1 - lb) * jax.nn.sigmoid(z.astype(F32))
    return chunk_scan(q.astype(F32), 1 - f, v.astype(F32), jnp.log(f), s0.astype(F32))


def hgrn_lower_bounds(logits, j):
    p = jax.nn.softmax(logits.astype(F32), axis=1)
    lb = jnp.cumsum(p, axis=1)[:, j].reshape(2, HGRN_HEADS, HGRN_DK)
    return lb[0], lb[1]


def hgrn_mixer(h, w_in, lb_f, lb_b, onorm, w_out, s0_f, s0_b):
    B, L, _ = h.shape
    q, zf, zb, i, g = jnp.split(h @ w_in, 5, axis=-1)
    heads = lambda t: t.reshape(B, L, HGRN_HEADS, -1)
    q, zf, zb, i = heads(q), heads(zf), heads(zb), heads(i)
    o_f, s_f = hgrn_direction(q, zf, i, lb_f, s0_f)
    o_b, s_b = hgrn_direction(q[:, ::-1], zb[:, ::-1], i[:, ::-1], lb_b, s0_b)
    o = (o_f + o_b[:, ::-1]).astype(h.dtype)
    o = rmsnorm(o, onorm).reshape(B, L, D_MODEL) * jax.nn.silu(g)
    return o @ w_out, s_f, s_b


def diff_attn_project(h, w_in):
    B, L, _ = h.shape
    q, k, v = jnp.split(h @ w_in, 3, axis=-1)
    return (q.reshape(B, L, 2 * DIFF_HEADS, DIFF_HD),
            k.reshape(B, L, 2 * DIFF_HEADS, DIFF_HD),
            v.reshape(B, L, DIFF_HEADS, 2 * DIFF_HD))


def diff_lambda(lam_p, lam_init):
    lp = lam_p.astype(F32)
    return jnp.exp(jnp.sum(lp[0] * lp[1])) - jnp.exp(jnp.sum(lp[2] * lp[3])) + lam_init


def diff_attention(q, k, v, lam, subln, lam_init):
    B, Lq = q.shape[:2]
    nb = Lq // Q_BLOCK
    qb = q.reshape(B, nb, Q_BLOCK, DIFF_HEADS, 2, DIFF_HD).transpose(1, 0, 2, 3, 4, 5)
    k5 = k.reshape(B, -1, DIFF_HEADS, 2, DIFF_HD).astype(F32)
    v32 = v.astype(F32)
    scale = DIFF_HD ** -0.5

    def block(qblk):
        s = jnp.einsum('bqhjd,bkhjd->bhjqk', qblk.astype(F32), k5) * scale
        p = jax.nn.softmax(s, axis=-1)
        a = p[:, :, 0] - lam * p[:, :, 1]
        return jnp.einsum('bhqk,bkhe->bqhe', a, v32)

    o = lax.map(block, qb)
    o = o.transpose(1, 0, 2, 3, 4).reshape(B, Lq, DIFF_HEADS, 2 * DIFF_HD)
    o = rmsnorm(o, subln) * (1 - lam_init)
    return o.reshape(B, Lq, D_MODEL).astype(q.dtype)


def conv_ffn(h, w_up, cw, cb, w_down):
    u = h @ w_up
    L = u.shape[1]
    up = jnp.pad(u, ((0, 0), (1, 1), (0, 0)))
    u = up[:, :L] * cw[0] + up[:, 1:L + 1] * cw[1] + up[:, 2:] * cw[2] + cb
    gate, val = jnp.split(u, 2, axis=-1)
    return (jax.nn.silu(gate) * val) @ w_down


def setup_inputs(seed: int = 0) -> dict:
    key = jax.random.key(seed)
    ks = jax.random.split(key, 24)
    D = D_MODEL
    nrm = lambda k, s, sc: jax.random.normal(k, s, F32) * sc
    return {
        'x_prompt': nrm(ks[0], (BATCH, SEQ, D), 1.0),
        'x_sample': nrm(ks[1], (DEC_BATCH, DEC_SEQ, D), 1.0),
        'c': nrm(ks[2], (DEC_BATCH, D), 1.0),
        'cache_hgrn_state': nrm(ks[3], (DEC_BATCH, N_HGRN, 2, HGRN_HEADS, HGRN_DK, HGRN_DV), 0.5),
        'cache_attn_k': nrm(ks[4], (DEC_BATCH, N_ATTN, PAST_LEN, 2 * DIFF_HEADS, DIFF_HD), 1.0),
        'cache_attn_v': nrm(ks[5], (DEC_BATCH, N_ATTN, PAST_LEN, DIFF_HEADS, 2 * DIFF_HD), 1.0),
        'c_ctx': nrm(ks[6], (D,), 1.0),
        'w_mod': nrm(ks[7], (DEPTH, D, 6 * D), 0.5 * D ** -0.5),
        'b_mod': nrm(ks[8], (DEPTH, 6 * D), 0.02),
        'norm_mix': 1.0 + nrm(ks[9], (DEPTH, D), 0.05),
        'norm_ffn': 1.0 + nrm(ks[10], (DEPTH, D), 0.05),
        'w_hgrn_in': nrm(ks[11], (N_HGRN, D, 5 * D), D ** -0.5),
        'hgrn_lb_logits': nrm(ks[12], (2, N_HGRN + 1, D), 0.5),
        'hgrn_onorm': 1.0 + nrm(ks[13], (N_HGRN, HGRN_DV), 0.05),
        'w_hgrn_out': nrm(ks[14], (N_HGRN, D, D), D ** -0.5),
        'w_attn_in': nrm(ks[15], (N_ATTN, D, 3 * D), D ** -0.5),
        'attn_lambda': nrm(ks[16], (N_ATTN, 4, DIFF_HD), 0.1),
        'attn_subln': 1.0 + nrm(ks[17], (N_ATTN, 2 * DIFF_HD), 0.05),
        'w_attn_out': nrm(ks[18], (N_ATTN, D, D), D ** -0.5),
        'w_ffn_up': nrm(ks[19], (DEPTH, D, 2 * D_FF), D ** -0.5),
        'ffn_conv_w': nrm(ks[20], (DEPTH, CONV_W, 2 * D_FF), CONV_W ** -0.5),
        'ffn_conv_b': nrm(ks[21], (DEPTH, 2 * D_FF), 0.02),
        'w_ffn_down': nrm(ks[22], (DEPTH, D_FF, D), D_FF ** -0.5),
        'norm_final': 1.0 + nrm(ks[23], (D,), 0.05),
    }


def reference(x_prompt, x_sample, c, cache_hgrn_state, cache_attn_k, cache_attn_v, c_ctx,
              w_mod, b_mod, norm_mix, norm_ffn, w_hgrn_in, hgrn_lb_logits, hgrn_onorm, w_hgrn_out,
              w_attn_in, attn_lambda, attn_subln, w_attn_out, w_ffn_up, ffn_conv_w, ffn_conv_b,
              w_ffn_down, norm_final):
    xp, xs = x_prompt, x_sample
    hgrn_states, attn_ks, attn_vs = [], [], []
    for l in range(DEPTH):
        mp = ada_mod(c_ctx[None, :], w_mod[l], b_mod[l])
        ms = ada_mod(c, w_mod[l], b_mod[l])
        hp = modulate(rmsnorm(xp, norm_mix[l]), mp[0], mp[1])
        hs = modulate(rmsnorm(xs, norm_mix[l]), ms[0], ms[1])
        j = l // N_MIXERS
        if l % N_MIXERS == 0:
            lb_f, lb_b = hgrn_lower_bounds(hgrn_lb_logits, j)
            zeros = jnp.zeros((xp.shape[0], HGRN_HEADS, HGRN_DK, HGRN_DV), F32)
            op, sf, sb = hgrn_mixer(hp, w_hgrn_in[j], lb_f, lb_b, hgrn_onorm[j], w_hgrn_out[j], zeros, zeros)
            hgrn_states.append(jnp.stack([sf, sb], axis=1).astype(xp.dtype))
            s0 = cache_hgrn_state[:, j]
            os_, _, _ = hgrn_mixer(hs, w_hgrn_in[j], lb_f, lb_b, hgrn_onorm[j], w_hgrn_out[j], s0[:, 0], s0[:, 1])
        else:
            lam_init = 0.8 - 0.6 * math.exp(-0.3 * l)
            lam = diff_lambda(attn_lambda[j], lam_init)
            qp, kp, vp = diff_attn_project(hp, w_attn_in[j])
            op = diff_attention(qp, kp, vp, lam, attn_subln[j], lam_init) @ w_attn_out[j]
            attn_ks.append(kp)
            attn_vs.append(vp)
            qs, ks_, vs_ = diff_attn_project(hs, w_attn_in[j])
            cos, sin = axial_rope(xs.shape[1], DIFF_HD)
            qs = apply_axial_rope(qs, cos, sin)
            ks_ = apply_axial_rope(ks_, cos, sin)
            k_all = jnp.concatenate([ks_, cache_attn_k[:, j].astype(ks_.dtype)], axis=1)
            v_all = jnp.concatenate([vs_, cache_attn_v[:, j].astype(vs_.dtype)], axis=1)
            os_ = diff_attention(qs, k_all, v_all, lam, attn_subln[j], lam_init) @ w_attn_out[j]
        xp = xp + mp[2] * op
        xs = xs + ms[2] * os_
        hp = modulate(rmsnorm(xp, norm_ffn[l]), mp[3], mp[4])
        hs = modulate(rmsnorm(xs, norm_ffn[l]), ms[3], ms[4])
        xp = xp + mp[5] * conv_ffn(hp, w_ffn_up[l], ffn_conv_w[l], ffn_conv_b[l], w_ffn_down[l])
        xs = xs + ms[5] * conv_ffn(hs, w_ffn_up[l], ffn_conv_w[l], ffn_conv_b[l], w_ffn_down[l])
    y_prompt = rmsnorm(xp, norm_final)
    y_sample = rmsnorm(xs, norm_final)
    new_hgrn_state = jnp.stack(hgrn_states, axis=1)
    new_attn_k = jnp.stack(attn_ks, axis=1)
    new_attn_v = jnp.stack(attn_vs, axis=1)
    return (y_prompt, y_sample, new_hgrn_state, new_attn_k, new_attn_v)
```

```cpp
#include <hip/hip_runtime.h>
#include <hip/hip_bf16.h>
#include <hip/hip_cooperative_groups.h>
#include <cstdio>
#include <cstdint>
namespace cg = cooperative_groups;
namespace pg8 {
#define PG8_LAS __attribute__((address_space(3)))
typedef unsigned short bf16_t;
typedef short bf16x8 __attribute__((ext_vector_type(8)));
typedef float f32x4 __attribute__((ext_vector_type(4)));
typedef unsigned u32x4 __attribute__((ext_vector_type(4)));
constexpr int BM = 256, BK = 64, HALF = 128, HTB = HALF * BK * 2  , STAGE_BYTES = 8 * HTB, NXCD = 8, WGM = 4;

__host__ __device__ __forceinline__ int lds_byte(int r, int c) { const int st = (r >> 4) * 2 + (c >> 5), rr = r & 15, cc = c & 31, ob = rr * 64 + cc * 2; return st * 1024 + (ob ^ (((ob >> 9) & 1) << 5)); }
__host__ __device__ __forceinline__ void stage_rc(int b, int& R, int& C) { const int st = b / 1024, sb = b % 1024, swz = sb ^ (((sb >> 9) & 1) << 5); R = (st >> 1) * 16 + swz / 64; C = (st & 1) * 32 + (swz % 64) / 2; }
__host__ __device__ __forceinline__ int perm32(int rho) { const int n = rho >> 4, i = rho & 15; return 8 * (i >> 2) + 4 * n + (i & 3); }

struct Unit { int pm, pn; };
struct Gemm { const bf16_t* A; const bf16_t* Bt; int M, N, K; };

struct StaticOrder {
    int nM, nN, nwg, G, c;
    __host__ __device__ void init(int M, int N, int G_, int c_) { nM = M / BM; nN = N / BM; nwg = nM * nN; G = G_; c = c_; }
    __host__ __device__ bool next(int i, Unit& u) const {
        const long L = (long)i * G + c; if (L >= nwg) return false;
        int wgid = (int)L; { const int q = nwg / NXCD, r = nwg % NXCD, xcd = wgid % NXCD, off = wgid / NXCD; wgid = (xcd < r ? xcd * (q + 1) : r * (q + 1) + (xcd - r) * q) + off; }
        const int nig = WGM * nN, gid = wgid / nig, fm = gid * WGM, gsz = (nM - fm) < WGM ? (nM - fm) : WGM;
        u.pm = fm + ((wgid % nig) % gsz); u.pn = (wgid % nig) / gsz; return true;
    }
    __device__ __forceinline__ void a_ready(const Unit&) const {}
    __device__ __forceinline__ void done(const Unit&) const {}
};

__device__ __forceinline__ unsigned cvt_pk_bf16(float lo, float hi) { unsigned r; asm volatile("v_cvt_pk_bf16_f32 %0, %1, %2" : "=v"(r) : "v"(lo), "v"(hi)); return r; }
template <class Epi, class Sched, bool ALIGN_EPI = false, bool SP2 = false>
__device__ __forceinline__ void gemm_phase(PG8_LAS unsigned char* lds, const Gemm g, const Sched& S, const Epi& E) {
    int tid_ = threadIdx.x; asm volatile("" : "+v"(tid_));
    const int tid = tid_, wid = __builtin_amdgcn_readfirstlane(tid >> 6), lane = tid & 63, wr = wid >> 2, wc = wid & 3, fr = lane & 15, fq = lane >> 4;
    const int K = g.K, nt = K / BK;
    unsigned voffA[2], voffB[2];
#pragma unroll
    for (int i = 0; i < 2; ++i) { int R, C; stage_rc(tid * 16 + i * 8192, R, C); const int Rb = Epi::PERM ? ((R & ~31) + perm32(R & 31)) : R;
        voffA[i] = (unsigned)(R * K + C) * 2u; voffB[i] = (unsigned)(Rb * K + C) * 2u; }
    const size_t kstep = (size_t)(BK * 2);
    const size_t hstep = (size_t)HALF * K * 2;
    const size_t tstep = 2 * hstep;
    const unsigned ldsw = (unsigned)wid * 1024u;
    const int aoff = lds_byte(wr * 64 + fr, fq * 8), boff = lds_byte(wc * 32 + fr, fq * 8);
#define PG8_SA(b, h) (((b) * 2 + (h)) * HTB)
#define PG8_SB(b, h) ((4 + (b) * 2 + (h)) * HTB)
#define PG8_STAGE(bufoff, gbase, voff) do { _Pragma("unroll") for (int _i = 0; _i < 2; ++_i) \
        __builtin_amdgcn_global_load_lds((const unsigned*)((const char*)(gbase) + (voff)[_i]), (PG8_LAS unsigned*)(lds + (bufoff) + ldsw + _i * 8192), 16, 0, 0); } while (0)
#define PG8_LDA(dst, b, h) do { _Pragma("unroll") for (int m = 0; m < 4; ++m) _Pragma("unroll") for (int k = 0; k < 2; ++k) dst[m][k] = *(const PG8_LAS bf16x8*)(lds + PG8_SA(b, h) + aoff + m * 2048 + k * 1024); } while (0)
#define PG8_LDB(dst, b, h) do { _Pragma("unroll") for (int n = 0; n < 2; ++n) _Pragma("unroll") for (int k = 0; k < 2; ++k) dst[n][k] = *(const PG8_LAS bf16x8*)(lds + PG8_SB(b, h) + boff + n * 2048 + k * 1024); } while (0)
#define PG8_MMA(ai, bj, At, Bt) do { __builtin_amdgcn_s_setprio(1); _Pragma("unroll") for (int m = 0; m < 4; ++m) _Pragma("unroll") for (int n = 0; n < 2; ++n) _Pragma("unroll") for (int k = 0; k < 2; ++k) \
        acc[ai][bj][m][n] = __builtin_amdgcn_mfma_f32_16x16x32_bf16(Bt[n][k], At[m][k], acc[ai][bj][m][n], 0, 0, 0); __builtin_amdgcn_s_setprio(0); } while (0)
#define PG8_WAIT_V(n) asm volatile("s_waitcnt vmcnt(" #n ")" ::: "memory")
#define PG8_WAIT_L(n) asm volatile("s_waitcnt lgkmcnt(" #n ")" ::: "memory")
#define PG8_BAR __builtin_amdgcn_s_barrier()
#define PG8_SCHED __builtin_amdgcn_sched_barrier(0)
    Unit cur, nxt; int ui = 0;
    if (!S.next(0, cur)) return;
    f32x4 acc[2][2][4][2];
#pragma unroll
    for (int a = 0; a < 2; ++a)
#pragma unroll
        for (int b = 0; b < 2; ++b)
#pragma unroll
            for (int m = 0; m < 4; ++m)
#pragma unroll
                for (int n = 0; n < 2; ++n) acc[a][b][m][n] = (f32x4){0.f, 0.f, 0.f, 0.f};
    bf16x8 At[4][2], B0[2][2], B1[2][2];
    const char* cA = (const char*)g.A + (size_t)cur.pm * tstep; const char* cB = (const char*)g.Bt + (size_t)cur.pn * tstep;
    S.a_ready(cur);
    if constexpr (SP2) {
        PG8_STAGE(PG8_SB(0, 0), cB, voffB); PG8_STAGE(PG8_SB(0, 1), cB + hstep, voffB); PG8_STAGE(PG8_SA(0, 0), cA, voffA); PG8_STAGE(PG8_SA(0, 1), cA + hstep, voffA);
        if (wr == 1) PG8_BAR;
        PG8_WAIT_V(2); PG8_BAR;
        PG8_STAGE(PG8_SB(1, 0), cB + kstep, voffB); PG8_STAGE(PG8_SA(1, 0), cA + kstep, voffA); PG8_STAGE(PG8_SB(1, 1), cB + hstep + kstep, voffB);
        PG8_WAIT_V(6); PG8_BAR;
    } else {
        PG8_STAGE(PG8_SB(0, 0), cB, voffB); PG8_STAGE(PG8_SA(0, 0), cA, voffA); PG8_STAGE(PG8_SB(0, 1), cB + hstep, voffB); PG8_STAGE(PG8_SA(0, 1), cA + hstep, voffA);
        if (wr == 1) PG8_BAR;
        PG8_WAIT_V(4); PG8_BAR;
        PG8_STAGE(PG8_SB(1, 0), cB + kstep, voffB); PG8_STAGE(PG8_SA(1, 0), cA + kstep, voffA); PG8_STAGE(PG8_SB(1, 1), cB + hstep + kstep, voffB);
        PG8_WAIT_V(6); PG8_BAR;
    }
    for (;;) {
        const bool has_next = S.next(ui + 1, nxt);
        const char* nA = has_next ? (const char*)g.A + (size_t)nxt.pm * tstep : cA; const char* nB = has_next ? (const char*)g.Bt + (size_t)nxt.pn * tstep : cB;
        for (int t = 0; t < nt; t += 2) {
            const bool last = (t == nt - 2);
            const char* a1 = cA + (size_t)(t + 1) * kstep;
            const char* a2 = last ? nA : cA + (size_t)(t + 2) * kstep; const char* b2 = last ? nB : cB + (size_t)(t + 2) * kstep;
            const char* a3 = a2 + kstep; const char* b3 = b2 + kstep;
            if (last && has_next) S.a_ready(nxt);
            if constexpr (SP2) {
            PG8_LDB(B0, 0, 0); PG8_LDB(B1, 0, 1); PG8_SCHED; PG8_LDA(At, 0, 0); PG8_STAGE(PG8_SA(1, 1), a1 + hstep, voffA);
            PG8_WAIT_V(8); PG8_WAIT_L(0); PG8_BAR; PG8_MMA(0, 0, At, B0); PG8_MMA(0, 1, At, B1); PG8_BAR; PG8_SCHED;
            PG8_LDA(At, 0, 1); PG8_STAGE(PG8_SB(0, 0), b2, voffB); PG8_STAGE(PG8_SB(0, 1), b2 + hstep, voffB); PG8_STAGE(PG8_SA(0, 0), a2, voffA);
            PG8_WAIT_V(8); PG8_WAIT_L(0); PG8_BAR; PG8_MMA(1, 0, At, B0); PG8_MMA(1, 1, At, B1); PG8_BAR; PG8_SCHED;
            PG8_LDB(B0, 1, 0); PG8_LDB(B1, 1, 1); PG8_SCHED; PG8_LDA(At, 1, 0); PG8_STAGE(PG8_SA(0, 1), a2 + hstep, voffA);
            PG8_WAIT_V(8); PG8_WAIT_L(0); PG8_BAR; PG8_MMA(0, 0, At, B0); PG8_MMA(0, 1, At, B1); PG8_BAR; PG8_SCHED;
            PG8_LDA(At, 1, 1); PG8_STAGE(PG8_SB(1, 0), b3, voffB); PG8_STAGE(PG8_SB(1, 1), b3 + hstep, voffB); PG8_STAGE(PG8_SA(1, 0), a3, voffA);
            PG8_WAIT_V(8); PG8_WAIT_L(0); PG8_BAR; PG8_MMA(1, 0, At, B0); PG8_MMA(1, 1, At, B1); PG8_BAR; PG8_SCHED;
            } else {
            PG8_LDB(B0, 0, 0); PG8_SCHED; PG8_LDA(At, 0, 0); PG8_STAGE(PG8_SA(1, 1), a1 + hstep, voffA);
            PG8_WAIT_L(8); PG8_BAR; PG8_WAIT_L(0); PG8_MMA(0, 0, At, B0); PG8_BAR; PG8_SCHED;
            PG8_LDB(B1, 0, 1); PG8_STAGE(PG8_SB(0, 0), b2, voffB);
            PG8_BAR; PG8_WAIT_L(0); PG8_MMA(0, 1, At, B1); PG8_BAR;
            PG8_LDA(At, 0, 1); PG8_STAGE(PG8_SA(0, 0), a2, voffA);
            PG8_BAR; PG8_WAIT_L(0); PG8_MMA(1, 0, At, B0); PG8_BAR; PG8_SCHED;
            PG8_STAGE(PG8_SB(0, 1), b2 + hstep, voffB);
            PG8_WAIT_V(6); PG8_BAR; PG8_MMA(1, 1, At, B1); PG8_BAR;
            PG8_LDB(B0, 1, 0); PG8_SCHED; PG8_LDA(At, 1, 0); PG8_STAGE(PG8_SA(0, 1), a2 + hstep, voffA);
            PG8_WAIT_L(8); PG8_BAR; PG8_WAIT_L(0); PG8_MMA(0, 0, At, B0); PG8_BAR; PG8_SCHED;
            PG8_LDB(B1, 1, 1); PG8_STAGE(PG8_SB(1, 0), b3, voffB);
            PG8_BAR; PG8_WAIT_L(0); PG8_MMA(0, 1, At, B1); PG8_BAR;
            PG8_LDA(At, 1, 1); PG8_STAGE(PG8_SA(1, 0), a3, voffA);
            PG8_BAR; PG8_WAIT_L(0); PG8_MMA(1, 0, At, B0); PG8_BAR; PG8_SCHED;
            PG8_STAGE(PG8_SB(1, 1), b3 + hstep, voffB);
            PG8_WAIT_V(6); PG8_BAR; PG8_MMA(1, 1, At, B1); PG8_BAR;
            }
        }
        if constexpr (ALIGN_EPI) { if (wr == 0) PG8_BAR; }
        if constexpr (!Epi::AFTER_DRAIN) { E(acc, cur, wr, wc, fr, fq); S.done(cur); }
        if (!has_next) break;
#pragma unroll
        for (int a = 0; a < 2; ++a)
#pragma unroll
            for (int b = 0; b < 2; ++b)
#pragma unroll
                for (int m = 0; m < 4; ++m)
#pragma unroll
                    for (int n = 0; n < 2; ++n) acc[a][b][m][n] = (f32x4){0.f, 0.f, 0.f, 0.f};
        cur = nxt; cA = nA; cB = nB; ++ui;
        if constexpr (ALIGN_EPI) { if (wr == 1) PG8_BAR; }
    }
    PG8_WAIT_V(0);
    if constexpr (!ALIGN_EPI) { if (wr == 0) PG8_BAR; }
    PG8_BAR;
    if constexpr (Epi::AFTER_DRAIN) { E.fused(acc, cur, wr, wc, fr, fq, lds, wid, lane); S.done(cur); }
#undef PG8_SA
#undef PG8_SB
#undef PG8_STAGE
#undef PG8_LDA
#undef PG8_LDB
#undef PG8_MMA
#undef PG8_WAIT_V
#undef PG8_WAIT_L
#undef PG8_BAR
#undef PG8_SCHED
}
}

namespace att {
using bf16 = __hip_bfloat16;
constexpr int   D = 128, NW = 8, QBLK = 32, KVBLK = 64;
constexpr float SCALE = 0.088388347648318440f;
constexpr float THR = 8.f;
constexpr int SDEPTH = 2;
constexpr int LDQ = 2048, LDK = 2048, LDO = 4096;
constexpr size_t SHM_V = KVBLK * D * 2, SHM_K = KVBLK * D * 2, SHM_ATTN = 2 * SHM_V + 2 * SHM_K + NW * 64 * 4;
using bf16x8 = __attribute__((ext_vector_type(8))) short;
using s16x4  = __attribute__((ext_vector_type(4))) short;
using f32x16 = __attribute__((ext_vector_type(16))) float;
using f32x8  = __attribute__((ext_vector_type(8))) float;
using u32x4  = __attribute__((ext_vector_type(4))) unsigned;
#define KSWZ(row, colB) ((row) * 256 + ((colB) ^ (((row) & 7) << 4)))
#define SBAR() __builtin_amdgcn_sched_barrier(0)
__device__ __forceinline__ int crow(int r, int hi) { return (r & 3) + 8 * (r >> 2) + 4 * hi; }
__device__ __forceinline__ unsigned cvtpk(float lo, float hi) {
  unsigned r; asm volatile("v_cvt_pk_bf16_f32 %0, %1, %2" : "=v"(r) : "v"(lo), "v"(hi)); return r;
}
template <typename TIn> struct Stage;
template <> struct Stage<bf16>  { using T = bf16x8;
  __device__ static __forceinline__ T ld8(const bf16* p) { return *reinterpret_cast<const bf16x8*>(p); }
  __device__ static __forceinline__ bf16x8 tobf(T x) { return x; } };
template <> struct Stage<float> { using T = f32x8;
  __device__ static __forceinline__ T ld8(const float* p) { return *reinterpret_cast<const f32x8*>(p); }
  __device__ static __forceinline__ bf16x8 tobf(T x) {
    u32x4 w = {cvtpk(x[0], x[1]), cvtpk(x[2], x[3]), cvtpk(x[4], x[5]), cvtpk(x[6], x[7])}; return *reinterpret_cast<bf16x8*>(&w); } };

__device__ __forceinline__ void partialSM(f32x16& p0, f32x16& p1, float& m_reg, float& mn, float& alpha) {
  constexpr float C = SCALE * 1.4426950408889634f;
  float pmax = p0[0]; for (int r = 1; r < 16; ++r) pmax = fmaxf(pmax, p0[r]); for (int r = 0; r < 16; ++r) pmax = fmaxf(pmax, p1[r]);
  { auto rr = __builtin_amdgcn_permlane32_swap(__float_as_uint(pmax), __float_as_uint(pmax), false, false);
    pmax = fmaxf(__uint_as_float(rr[0]), __uint_as_float(rr[1])); }
  if (__builtin_expect(__all(pmax - m_reg <= THR / SCALE), 1)) { mn = m_reg; alpha = 1.f; }
  else { mn = fmaxf(m_reg, pmax); alpha = __builtin_amdgcn_exp2f((m_reg - mn) * C); m_reg = mn; }
  float mnC = -mn * C;
  for (int r = 0; r < 16; ++r) p0[r] = fmaf(p0[r], C, mnC); for (int r = 0; r < 16; ++r) p1[r] = fmaf(p1[r], C, mnC);
  for (int r = 0; r < 16; ++r) p0[r] = __builtin_amdgcn_exp2f(p0[r]);
}
__device__ __forceinline__ void finishSM(f32x16& p0, f32x16& p1, float alpha, float& l_reg, bf16x8& pa0, bf16x8& pa1, bf16x8& pa2, bf16x8& pa3) {
  for (int r = 0; r < 16; ++r) p1[r] = __builtin_amdgcn_exp2f(p1[r]);
  float ps = 0; for (int r = 0; r < 16; ++r) ps += p0[r]; for (int r = 0; r < 16; ++r) ps += p1[r];
  { auto rr = __builtin_amdgcn_permlane32_swap(__float_as_uint(ps), __float_as_uint(ps), false, false);
    ps = __uint_as_float(rr[0]) + __uint_as_float(rr[1]); }
  l_reg = l_reg * alpha + ps;
#define PK4(P, BASE, OUT) do { unsigned a0 = cvtpk(P[BASE + 0], P[BASE + 1]), a1 = cvtpk(P[BASE + 2], P[BASE + 3]);   \
    unsigned b0 = cvtpk(P[BASE + 4], P[BASE + 5]), b1 = cvtpk(P[BASE + 6], P[BASE + 7]);                              \
    auto r0 = __builtin_amdgcn_permlane32_swap(a0, b0, false, false); auto r1 = __builtin_amdgcn_permlane32_swap(a1, b1, false, false); \
    u32x4 w = {r0[0], r1[0], r0[1], r1[1]}; OUT = *reinterpret_cast<bf16x8*>(&w); } while (0)
  PK4(p0, 0, pa0); PK4(p0, 8, pa1); PK4(p1, 0, pa2); PK4(p1, 8, pa3);
#undef PK4
}
__device__ __forceinline__ void qkt(f32x16& p0, f32x16& p1, const bf16* Ks, const bf16x8* qr, int r32, int hi) {
  p0 = f32x16{}; p1 = f32x16{};
  for (int d0 = 0; d0 < 8; ++d0) { int cb = (d0 * 16 + hi * 8) * 2;
    bf16x8 b0 = *reinterpret_cast<const bf16x8*>((const char*)Ks + KSWZ(r32, cb));
    bf16x8 b1 = *reinterpret_cast<const bf16x8*>((const char*)Ks + KSWZ(32 + r32, cb));
    p0 = __builtin_amdgcn_mfma_f32_32x32x16_bf16(b0, qr[d0], p0, 0, 0, 0);
    p1 = __builtin_amdgcn_mfma_f32_32x32x16_bf16(b1, qr[d0], p1, 0, 0, 0); }
}
__device__ __forceinline__ int v_st(int k, int c) { const int kk = (k & ~0xC) | ((k & 4) << 1) | ((k & 8) >> 1); return ((kk >> 3) * 4 + (c >> 5)) * 512 + ((kk & 7) * 32 + (c & 31)) * 2; }
__device__ __forceinline__ int v_rd_base(int lane) { return ((lane & 3) << 3) | (((lane >> 2) & 3) << 6) | (((lane >> 4) & 1) << 5) | (((lane >> 5) & 1) << 8); }
constexpr int v_rd_off(int d0, int ks, int half) { return d0 * 512 + ks * 4096 + half * 2048; }
template <int OFF> __device__ __forceinline__ s16x4 tr_read(int vb) {
  s16x4 r; asm volatile("ds_read_b64_tr_b16 %0, %1 offset:%2" : "=&v"(r) : "v"(vb), "i"(OFF) : "memory"); return r;
}
template <int D0> __device__ __forceinline__ void pv_one(f32x16& od, int vb, bf16x8 pa0, bf16x8 pa1, bf16x8 pa2, bf16x8 pa3) {
  const s16x4 l0 = tr_read<v_rd_off(D0, 0, 0)>(vb), h0 = tr_read<v_rd_off(D0, 0, 1)>(vb), l1 = tr_read<v_rd_off(D0, 1, 0)>(vb), h1 = tr_read<v_rd_off(D0, 1, 1)>(vb);
  const s16x4 l2 = tr_read<v_rd_off(D0, 2, 0)>(vb), h2 = tr_read<v_rd_off(D0, 2, 1)>(vb), l3 = tr_read<v_rd_off(D0, 3, 0)>(vb), h3 = tr_read<v_rd_off(D0, 3, 1)>(vb);
  asm volatile("s_waitcnt lgkmcnt(0)" ::: "memory"); SBAR();
#define PK(L, H) (bf16x8){L[0], L[1], L[2], L[3], H[0], H[1], H[2], H[3]}
  od = __builtin_amdgcn_mfma_f32_32x32x16_bf16(pa0, PK(l0, h0), od, 0, 0, 0);
  od = __builtin_amdgcn_mfma_f32_32x32x16_bf16(pa1, PK(l1, h1), od, 0, 0, 0);
  od = __builtin_amdgcn_mfma_f32_32x32x16_bf16(pa2, PK(l2, h2), od, 0, 0, 0);
  od = __builtin_amdgcn_mfma_f32_32x32x16_bf16(pa3, PK(l3, h3), od, 0, 0, 0);
#undef PK
}
__device__ __forceinline__ void pv_d0(f32x16* o, int vb, bf16x8 pa0, bf16x8 pa1, bf16x8 pa2, bf16x8 pa3) {
  pv_one<0>(o[0], vb, pa0, pa1, pa2, pa3); pv_one<1>(o[1], vb, pa0, pa1, pa2, pa3); pv_one<2>(o[2], vb, pa0, pa1, pa2, pa3); pv_one<3>(o[3], vb, pa0, pa1, pa2, pa3);
}


__device__ __forceinline__ void att_lds_barrier() { asm volatile("s_waitcnt lgkmcnt(0)\n\ts_barrier" ::: "memory"); }
template <typename TQ>
__device__ __forceinline__ void attn_dense_body(const TQ* __restrict__ Qb, const bf16* __restrict__ Kh, const bf16* __restrict__ Vh,
                                                bf16* __restrict__ Ob, int seq, char* lds) {
  using St = Stage<bf16>; using SQ = Stage<TQ>;
  int tid_ = threadIdx.x; asm volatile("" : "+v"(tid_));
  const int tid = tid_, wid = tid >> 6, lane = tid & 63, r32 = lane & 31, hi = lane >> 5;
  bf16* V_lds = (bf16*)lds; bf16* K_lds = (bf16*)(lds + 2 * SHM_V);
  float* ws = (float*)(lds + 2 * SHM_V + 2 * SHM_K) + wid * 64; float* li_l = ws; float* al_l = ws + 32;
  float m_reg = -1e30f, l_reg = 0; f32x16 o[4] = {}; bf16x8 qr[8];
  const TQ* Qw = Qb + (long)(wid * QBLK + r32) * LDQ + hi * 8;
#pragma unroll
  for (int d0 = 0; d0 < 8; ++d0) qr[d0] = SQ::tobf(SQ::ld8(Qw + d0 * 16));
  const int sr = tid >> 4, sc = (tid & 15) * 8, vst0 = v_st(sr, sc), vst1 = v_st(32 + sr, sc);
  const int vb0 = (int)(uintptr_t)V_lds + v_rd_base(lane);
  struct { typename St::T vs0, vs1, ks0, ks1; } sr_[SDEPTH];
#define SLOAD(i, k0) do { sr_[i].vs0 = St::ld8(&Vh[(long)((k0) + sr) * LDK + sc]); sr_[i].vs1 = St::ld8(&Vh[(long)((k0) + 32 + sr) * LDK + sc]); \
    sr_[i].ks0 = St::ld8(&Kh[(long)((k0) + sr) * LDK + sc]); sr_[i].ks1 = St::ld8(&Kh[(long)((k0) + 32 + sr) * LDK + sc]); } while (0)
#define SWRITE(b, i) do { *(bf16x8*)((char*)V_lds + (b) * SHM_V + vst0) = St::tobf(sr_[i].vs0);          \
    *(bf16x8*)((char*)V_lds + (b) * SHM_V + vst1) = St::tobf(sr_[i].vs1); int kc = sc * 2;               \
    *(bf16x8*)((char*)K_lds + (b) * SHM_K + KSWZ(sr, kc)) = St::tobf(sr_[i].ks0);                       \
    *(bf16x8*)((char*)K_lds + (b) * SHM_K + KSWZ(32 + sr, kc)) = St::tobf(sr_[i].ks1); } while (0)
#define SWAIT() do { if constexpr (SDEPTH == 2) asm volatile("s_waitcnt vmcnt(4)" ::: "memory"); else asm volatile("s_waitcnt vmcnt(0)" ::: "memory"); } while (0)
#define RESC(a) do { if (__any((a) < 1.f)) { if (hi == 0) al_l[r32] = (a); asm volatile("s_waitcnt lgkmcnt(0)" ::: "memory"); \
    for (int d = 0; d < 4; ++d) for (int r = 0; r < 16; ++r) o[d][r] *= al_l[crow(r, hi)]; } } while (0)
  f32x16 pA0, pA1, pB0, pB1; float mnA, mnB, alA, alB; bf16x8 pa0, pa1, pa2, pa3; const int NT = seq / KVBLK;
  constexpr int SE = 0, SO = SDEPTH - 1;
  SLOAD(SE, 0); asm volatile("s_waitcnt vmcnt(0)" ::: "memory"); SWRITE(0, SE); att_lds_barrier();
  qkt(pA0, pA1, K_lds, qr, r32, hi); partialSM(pA0, pA1, m_reg, mnA, alA);
  SLOAD(SO, KVBLK); if constexpr (SDEPTH == 2) { if (2 < NT) SLOAD(SE, 2 * KVBLK); }
  SWAIT(); SWRITE(1, SO); att_lds_barrier();
  for (int j = 1; j + 1 < NT; j += 2) {
    SBAR(); qkt(pB0, pB1, (bf16*)((char*)K_lds + SHM_K), qr, r32, hi);
    finishSM(pA0, pA1, alA, l_reg, pa0, pa1, pa2, pa3); SBAR();
    SLOAD(SO, (j + SDEPTH) * KVBLK); SBAR();
    pv_d0(o, vb0, pa0, pa1, pa2, pa3); partialSM(pB0, pB1, m_reg, mnB, alB);
    att_lds_barrier(); SWAIT(); SWRITE(0, SE);
    RESC(alB); att_lds_barrier();
    SBAR(); qkt(pA0, pA1, K_lds, qr, r32, hi);
    finishSM(pB0, pB1, alB, l_reg, pa0, pa1, pa2, pa3); SBAR();
    if (SDEPTH == 1 || j + 3 < NT) SLOAD(SE, (j + 1 + SDEPTH) * KVBLK); SBAR();
    pv_d0(o, vb0 + (int)SHM_V, pa0, pa1, pa2, pa3); partialSM(pA0, pA1, m_reg, mnA, alA);
    att_lds_barrier(); SWAIT(); SWRITE(1, SO);
    RESC(alA); att_lds_barrier();
  }
  SBAR(); qkt(pB0, pB1, (bf16*)((char*)K_lds + SHM_K), qr, r32, hi);
  finishSM(pA0, pA1, alA, l_reg, pa0, pa1, pa2, pa3); SBAR();
  pv_d0(o, vb0, pa0, pa1, pa2, pa3); partialSM(pB0, pB1, m_reg, mnB, alB);
  att_lds_barrier(); RESC(alB);
  finishSM(pB0, pB1, alB, l_reg, pa0, pa1, pa2, pa3); SBAR();
  pv_d0(o, vb0 + (int)SHM_V, pa0, pa1, pa2, pa3);
  if (hi == 0) li_l[r32] = l_reg; asm volatile("s_waitcnt lgkmcnt(0)" ::: "memory");
  float rli[16];
#pragma unroll
  for (int r = 0; r < 16; ++r) rli[r] = __builtin_amdgcn_rcpf(li_l[crow(r, hi)]);
  bf16* Ow = Ob + (long)(wid * QBLK) * LDO;
#pragma unroll
  for (int r = 0; r < 16; ++r) { int orow = crow(r, hi);
    for (int d0 = 0; d0 < 4; ++d0) Ow[(long)orow * LDO + d0 * 32 + r32] = __float2bfloat16(o[d0][r] * rli[r]); }
#undef SLOAD
#undef SWRITE
#undef SWAIT
#undef RESC
}
#undef KSWZ
#undef SBAR
}

#define LAS __attribute__((address_space(3)))
typedef unsigned short bf16_t;
typedef float f32x4 __attribute__((ext_vector_type(4)));
typedef unsigned u32x4 __attribute__((ext_vector_type(4)));
typedef unsigned u32x2 __attribute__((ext_vector_type(2)));
typedef short bf16x8 __attribute__((ext_vector_type(8)));
typedef short s16x4v __attribute__((ext_vector_type(4)));

constexpr int DM = 2048, NPR = 4096, MTOT = 36864, DFF = 5632, NUP = 11264, NMOD = 12288;
constexpr float EPS = 1e-6f;
constexpr size_t MiB = (size_t)1 << 20;
constexpr size_t WS_MOD = 0, WS_LB = 1 * MiB, WS_ROPE = 1 * MiB + 65536, WS_BAR = 1 * MiB + 131072, BAR_BYTES = 16384;
constexpr size_t WS_WUP = 2 * MiB, WS_WDOWN = 46 * MiB, WS_WOUT = 68 * MiB, WS_WIN = 76 * MiB;
constexpr size_t WS_H = 116 * MiB, WS_B0 = 260 * MiB, SZ = 144 * MiB;
constexpr size_t WS_END = 1012 * MiB;
constexpr size_t OUT_STATE = (size_t)MTOT * DM, OUT_NK = OUT_STATE + 8388608, OUT_NV = OUT_NK + 8388608;
constexpr int LDS_BYTES = 147456;

__device__ __forceinline__ float fsigmoid(float z) { return __builtin_amdgcn_rcpf(1.f + __expf(-z)); }
__device__ __forceinline__ unsigned pkbf(float lo, float hi) { return pg8::cvt_pk_bf16(lo, hi); }
__device__ __forceinline__ float bflo(unsigned w) { return __uint_as_float(w << 16); }
__device__ __forceinline__ float bfhi(unsigned w) { return __uint_as_float(w & 0xffff0000u); }
typedef _Float16 h16x2 __attribute__((ext_vector_type(2)));
__device__ __forceinline__ unsigned pk_f16(float a, float b) { h16x2 v = {(_Float16)a, (_Float16)b}; return __builtin_bit_cast(unsigned, v); }
__device__ __forceinline__ float f16lo(unsigned w) { h16x2 v = __builtin_bit_cast(h16x2, w); return (float)v.x; }
__device__ __forceinline__ float f16hi(unsigned w) { h16x2 v = __builtin_bit_cast(h16x2, w); return (float)v.y; }
__device__ __forceinline__ float shx(float v, int o, int lane) { return __builtin_bit_cast(float, __builtin_amdgcn_ds_bpermute((lane ^ o) << 2, __builtin_bit_cast(int, v))); }
__device__ __forceinline__ float wave_sum(float v, int lane) {
#pragma unroll
    for (int o = 1; o < 64; o <<= 1) v += shx(v, o, lane);
    return v;
}
__device__ __forceinline__ void lds_barrier() { asm volatile("s_waitcnt lgkmcnt(0)\n\ts_barrier" ::: "memory"); }
template <int CTRL> __device__ __forceinline__ float dppf(float v) { return __builtin_bit_cast(float, __builtin_amdgcn_update_dpp(0, __builtin_bit_cast(int, v), CTRL, 0xf, 0xf, true)); }
__device__ __forceinline__ void unpack8(const u32x4 w, float* f) {
    f[0] = bflo(w.x); f[1] = bfhi(w.x); f[2] = bflo(w.y); f[3] = bfhi(w.y); f[4] = bflo(w.z); f[5] = bfhi(w.z); f[6] = bflo(w.w); f[7] = bfhi(w.w);
}
__device__ __forceinline__ u32x4 pack8(const float* f) { u32x4 w; w.x = pkbf(f[0], f[1]); w.y = pkbf(f[2], f[3]); w.z = pkbf(f[4], f[5]); w.w = pkbf(f[6], f[7]); return w; }

struct EpiHgrnIn {
    static constexpr bool PERM = true, AFTER_DRAIN = false;
    bf16_t* base; const float* lb;
    __device__ __forceinline__ void operator()(const pg8::f32x4 (&acc)[2][2][4][2], const pg8::Unit& u, int wr, int wc, int fr, int fq) const {
        int opq = 0; asm volatile("" : "+v"(opq));
        const int type = u.pn >> 3;
        const int cb = (u.pn & 7) * 256 + wc * 32 + 8 * fq + opq;
        const int row0 = u.pm * 256 + wr * 64 + fr;
        if (type == 1 || type == 2) {
            bf16_t* dst = base + (size_t)type * (SZ / 2); const float* lbp = lb + (type - 1) * DM;
#pragma unroll
            for (int bj = 0; bj < 2; ++bj) { const int col = cb + bj * 128;
                const f32x4 l0 = *(const f32x4*)(lbp + col), l1 = *(const f32x4*)(lbp + col + 4);
#pragma unroll
                for (int ai = 0; ai < 2; ++ai)
#pragma unroll
                    for (int m = 0; m < 4; ++m) { const size_t row = row0 + ai * 128 + m * 16;
                        const f32x4 z0 = acc[ai][bj][m][0], z1 = acc[ai][bj][m][1]; float lf[8];
#pragma unroll
                        for (int e = 0; e < 4; ++e) { lf[e] = __log2f(l0[e] + (1.f - l0[e]) * fsigmoid(z0[e])); lf[4 + e] = __log2f(l1[e] + (1.f - l1[e]) * fsigmoid(z1[e])); }
                        u32x4 w; w.x = pk_f16(lf[0], lf[1]); w.y = pk_f16(lf[2], lf[3]); w.z = pk_f16(lf[4], lf[5]); w.w = pk_f16(lf[6], lf[7]);
                        *(u32x4*)(dst + row * DM + col) = w; } }
        } else {
            bf16_t* dst = base + (size_t)type * (SZ / 2);
#pragma unroll
            for (int bj = 0; bj < 2; ++bj) { const int col = cb + bj * 128;
#pragma unroll
                for (int ai = 0; ai < 2; ++ai)
#pragma unroll
                    for (int m = 0; m < 4; ++m) { const size_t row = row0 + ai * 128 + m * 16;
                        const f32x4 v0 = acc[ai][bj][m][0], v1 = acc[ai][bj][m][1];
                        u32x4 w; w.x = pkbf(v0[0], v0[1]); w.y = pkbf(v0[2], v0[3]); w.z = pkbf(v1[0], v1[1]); w.w = pkbf(v1[2], v1[3]);
                        *(u32x4*)(dst + row * DM + col) = w; } }
        }
    }
};
struct EpiResid {
    static constexpr bool PERM = true, AFTER_DRAIN = false;
    const float* x0; const float* x1; float* out; const float* gate;
    __device__ __forceinline__ void operator()(const pg8::f32x4 (&acc)[2][2][4][2], const pg8::Unit& u, int wr, int wc, int fr, int fq) const {
        int opq = 0; asm volatile("" : "+v"(opq));
        const int cb = u.pn * 256 + wc * 32 + 8 * fq + opq;
        const int row0 = u.pm * 256 + wr * 64 + fr;
        const float* gp = gate + (size_t)((u.pm * 256) >> 12) * NMOD;
        const float* src0 = (u.pm < 16) ? x0 : x1 - (size_t)NPR * DM;
#pragma unroll
        for (int bj = 0; bj < 2; ++bj) { const int col = cb + bj * 128;
            const f32x4 g0 = *(const f32x4*)(gp + col), g1 = *(const f32x4*)(gp + col + 4);
#pragma unroll
            for (int ai = 0; ai < 2; ++ai) { f32x4 xa[4], xb[4];
#pragma unroll
                for (int m = 0; m < 4; ++m) { const size_t off = (size_t)(row0 + ai * 128 + m * 16) * DM + col; xa[m] = *(const f32x4*)(src0 + off); xb[m] = *(const f32x4*)(src0 + off + 4); }
#pragma unroll
                for (int m = 0; m < 4; ++m) { const size_t off = (size_t)(row0 + ai * 128 + m * 16) * DM + col;
                    *(f32x4*)(out + off) = xa[m] + g0 * acc[ai][bj][m][0]; *(f32x4*)(out + off + 4) = xb[m] + g1 * acc[ai][bj][m][1]; }
                asm volatile("" ::: "memory"); } }
    }
};
struct EpiFfnUp {
    static constexpr bool PERM = true, AFTER_DRAIN = false;
    bf16_t* A; bf16_t* halo; const float* cw; const float* cbias;
    __device__ __forceinline__ void operator()(const pg8::f32x4 (&acc)[2][2][4][2], const pg8::Unit& u, int wr, int wc, int fr, int fq) const {
        int opq = 0; asm volatile("" : "+v"(opq));
        const int c0 = u.pn * 128 + wc * 32 + 8 * fq + opq;
        const int rowg = u.pm * 256 + wr * 64;
#pragma unroll
        for (int n = 0; n < 2; ++n) { const int cg = c0 + 4 * n, cv = DFF + cg;
            const f32x4 g0 = *(const f32x4*)(cw + cg), g1 = *(const f32x4*)(cw + NUP + cg), g2 = *(const f32x4*)(cw + 2 * NUP + cg), gb = *(const f32x4*)(cbias + cg);
            const f32x4 v0 = *(const f32x4*)(cw + cv), v1 = *(const f32x4*)(cw + NUP + cv), v2 = *(const f32x4*)(cw + 2 * NUP + cv), vb = *(const f32x4*)(cbias + cv);
#pragma unroll
            for (int ai = 0; ai < 2; ++ai)
#pragma unroll
                for (int m = 0; m < 4; ++m) {
                    const f32x4 ug = acc[ai][0][m][n], uv = acc[ai][1][m][n]; f32x4 pg, ng, pv, nv;
#pragma unroll
                    for (int e = 0; e < 4; ++e) {
                        pg[e] = dppf<0x111>(ug[e]); ng[e] = dppf<0x101>(ug[e]); pv[e] = dppf<0x111>(uv[e]); nv[e] = dppf<0x101>(uv[e]);
                        if (m > 0) { pg[e] += dppf<0x10F>(acc[ai][0][m > 0 ? m - 1 : 0][n][e]); pv[e] += dppf<0x10F>(acc[ai][1][m > 0 ? m - 1 : 0][n][e]); }
                        if (m < 3) { ng[e] += dppf<0x11F>(acc[ai][0][m < 3 ? m + 1 : 3][n][e]); nv[e] += dppf<0x11F>(acc[ai][1][m < 3 ? m + 1 : 3][n][e]); } }
                    const f32x4 cgv = g0 * pg + g1 * ug + g2 * ng + gb, cvv = v0 * pv + v1 * uv + v2 * nv + vb; f32x4 o;
#pragma unroll
                    for (int e = 0; e < 4; ++e) o[e] = cgv[e] * fsigmoid(cgv[e]) * cvv[e];
                    const int r = 16 * m + fr;
                    if (r != 0 && r != 63) { u32x2 w; w.x = pkbf(o[0], o[1]); w.y = pkbf(o[2], o[3]); *(u32x2*)(A + (size_t)(rowg + ai * 128 + r) * DFF + cg) = w; }
                    if (r <= 1 || r >= 62) { const int slot = r <= 1 ? r : r - 60; bf16_t* hp = halo + (size_t)(((rowg + ai * 128) >> 6) * 4 + slot) * NUP;
                        u32x2 wg, wv; wg.x = pkbf(ug[0], ug[1]); wg.y = pkbf(ug[2], ug[3]); wv.x = pkbf(uv[0], uv[1]); wv.y = pkbf(uv[2], uv[3]);
                        *(u32x2*)(hp + cg) = wg; *(u32x2*)(hp + cv) = wv; }
                } }
    }
};
struct EpiAttnIn {
    static constexpr bool PERM = true, AFTER_DRAIN = false;
    bf16_t *Q, *KA, *VA, *KP, *VP; float* nk; float* nv; const float* tab;
    __device__ __forceinline__ void operator()(const pg8::f32x4 (&acc)[2][2][4][2], const pg8::Unit& u, int wr, int wc, int fr, int fq) const {
        int opq = 0; asm volatile("" : "+v"(opq));
        const int type = u.pn >> 3;
        const int cb = (u.pn & 7) * 256 + wc * 32 + 8 * fq + opq;
        const int rl = wr * 64 + fr;
        const bool prompt = u.pm < 16;
        bf16_t* dst; float* fdst = nullptr; size_t drow0;
        if (type == 0) { dst = Q; drow0 = (size_t)u.pm * 256; }
        else if (prompt) { dst = type == 1 ? KP : VP; drow0 = (size_t)u.pm * 256; fdst = type == 1 ? nk : nv; }
        else { const int sb = (u.pm - 16) >> 4, t0 = ((u.pm - 16) & 15) * 256; dst = type == 1 ? KA : VA; drow0 = (size_t)sb * 4608 + t0; }
        if (type == 2) {
#pragma unroll
            for (int bj = 0; bj < 2; ++bj) { const int col = cb + bj * 128;
#pragma unroll
                for (int ai = 0; ai < 2; ++ai)
#pragma unroll
                    for (int m = 0; m < 4; ++m) { const size_t off = (drow0 + rl + ai * 128 + m * 16) * DM + col;
                        const f32x4 v0 = acc[ai][bj][m][0], v1 = acc[ai][bj][m][1];
                        u32x4 w; w.x = pkbf(v0[0], v0[1]); w.y = pkbf(v0[2], v0[3]); w.z = pkbf(v1[0], v1[1]); w.w = pkbf(v1[2], v1[3]);
                        *(u32x4*)(dst + off) = w;
                        if (fdst) { *(f32x4*)(fdst + off) = v0; *(f32x4*)(fdst + off + 4) = v1; } } }
        } else {
            const int ax = wc >> 1, f0 = 16 * (wc & 1) + 4 * fq;
            const int tb = prompt ? 0 : ((u.pm - 16) & 15) * 256 + wr * 64 + fr;
#pragma unroll
            for (int ai = 0; ai < 2; ++ai)
#pragma unroll
                for (int m = 0; m < 4; ++m) { const int t = tb + ai * 128 + m * 16, pos = ax ? (t & 63) : (t >> 6);
                    f32x4 c0 = {1.f, 0.f, 1.f, 0.f}, c1 = c0;
                    if (!prompt) { const float* tp = tab + (pos * 32 + f0) * 2; c0 = *(const f32x4*)tp; c1 = *(const f32x4*)(tp + 4); }
#pragma unroll
                    for (int bj = 0; bj < 2; ++bj) { const int col = cb + bj * 128; const size_t off = (drow0 + rl + ai * 128 + m * 16) * DM + col;
                        const f32x4 v0 = acc[ai][bj][m][0], v1 = acc[ai][bj][m][1]; f32x4 r0, r1;
                        r0[0] = v0[0] * c0[0] - v0[1] * c0[1]; r0[1] = v0[1] * c0[0] + v0[0] * c0[1]; r0[2] = v0[2] * c0[2] - v0[3] * c0[3]; r0[3] = v0[3] * c0[2] + v0[2] * c0[3];
                        r1[0] = v1[0] * c1[0] - v1[1] * c1[1]; r1[1] = v1[1] * c1[0] + v1[0] * c1[1]; r1[2] = v1[2] * c1[2] - v1[3] * c1[3]; r1[3] = v1[3] * c1[2] + v1[2] * c1[3];
                        u32x4 w; w.x = pkbf(r0[0], r0[1]); w.y = pkbf(r0[2], r0[3]); w.z = pkbf(r1[0], r1[1]); w.w = pkbf(r1[2], r1[3]);
                        *(u32x4*)(dst + off) = w;
                        if (fdst) { const size_t lo = (drow0 + rl + ai * 128 + m * 16) * DM + (u.pn & 7) * 256 + bj * 128 + ax * 64 + f0 + opq;
                            *(f32x4*)(fdst + lo) = (f32x4){v0[0], v0[2], v1[0], v1[2]}; *(f32x4*)(fdst + lo + 32) = (f32x4){v0[1], v0[3], v1[1], v1[3]}; } } }
        }
    }
};

__device__ __forceinline__ void transpose_item(const float* W, int K, int N, bf16_t* WT, int mode, LAS float* scr, int item, int lane) {
    const int nblk = N / 32, kb = item / nblk, nb = item % nblk, k0 = 64 * kb, n0 = 32 * nb;
    int d0 = n0, dstr = 1;
    if (mode == 1) d0 = n0 < DFF ? (n0 >> 7) * 256 + (n0 & 127) : ((n0 - DFF) >> 7) * 256 + 128 + ((n0 - DFF) & 127);
    if (mode == 2 && n0 < 2 * DM) { d0 = (n0 & ~127) + (n0 & 64) + ((n0 >> 5) & 1); dstr = 2; }
#pragma unroll 16
    for (int i = 0; i < 32; ++i) { const int kk = 2 * i + (lane >> 5); scr[kk * 33 + (lane & 31)] = W[(size_t)(k0 + kk) * N + n0 + (lane & 31)]; }
    asm volatile("s_waitcnt lgkmcnt(0)" ::: "memory");
    const int c = lane & 7;
#pragma unroll
    for (int j = 0; j < 4; ++j) { const int n = (lane >> 3) + 8 * j; const LAS float* s = scr + (8 * c) * 33 + n;
        u32x4 o; o.x = pkbf(s[0 * 33], s[1 * 33]); o.y = pkbf(s[2 * 33], s[3 * 33]); o.z = pkbf(s[4 * 33], s[5 * 33]); o.w = pkbf(s[6 * 33], s[7 * 33]);
        *(u32x4*)(WT + (size_t)(d0 + n * dstr) * K + k0 + 8 * c) = o; }
    asm volatile("s_waitcnt lgkmcnt(0)" ::: "memory");
}
__device__ __forceinline__ const float* KIN(int k);
__device__ __forceinline__ void transpose_layer(int l, unsigned char* ws, LAS unsigned char* lds, int tw, int ntw, int wave, int lane) {
    LAS float* scr = (LAS float*)(lds + wave * 16384);
    const float* Win = KIN(l == 0 ? 11 : 15); const int Nin = l == 0 ? 10240 : 6144;
    const float* Wout = KIN(l == 0 ? 14 : 18);
    const float* Wup = KIN(19) + (size_t)l * DM * NUP; const float* Wdn = KIN(22) + (size_t)l * DFF * DM;
    const int I_in = 32 * (Nin / 32), I_out = 32 * 64, I_up = 32 * (NUP / 32), I_dn = (DFF / 64) * 64;
    const int total = I_in + I_out + I_up + I_dn;
    for (int it = tw; it < total; it += ntw) { int r = it;
        if (r < I_up) { transpose_item(Wup, DM, NUP, (bf16_t*)(ws + WS_WUP), 1, scr, r, lane); continue; } r -= I_up;
        if (r < I_in) { transpose_item(Win, DM, Nin, (bf16_t*)(ws + WS_WIN), l == 1 ? 2 : 0, scr, r, lane); continue; } r -= I_in;
        if (r < I_dn) { transpose_item(Wdn, DFF, DM, (bf16_t*)(ws + WS_WDOWN), 0, scr, r, lane); continue; } r -= I_dn;
        transpose_item(Wout, DM, DM, (bf16_t*)(ws + WS_WOUT), 0, scr, r, lane); }
}
__device__ __forceinline__ void mod_task(int task, const float* cvec, const float* cctx, const float* wmod, const float* bmod, float* mod, LAS unsigned char* lds, int tid, int wave, int lane) {
    LAS float* sil = (LAS float*)lds;
    LAS float* red = (LAS float*)(lds + 12288);
    const int kq = task & 7, cl = task >> 3, l = cl / 48, cgp = cl % 48, kbase = kq * 256;
    for (int i = tid; i < 9 * 256; i += 512) { const int n = i >> 8, k = i & 255; const float c = n == 0 ? cctx[kbase + k] : cvec[(n - 1) * DM + kbase + k]; sil[k * 12 + n] = c / (1.f + expf(-c)); }
    __syncthreads();
    const float* W = wmod + (size_t)l * DM * NMOD + (size_t)kbase * NMOD + cgp * 256 + lane * 4;
    float acc[9][4];
#pragma unroll
    for (int n = 0; n < 9; ++n)
#pragma unroll
        for (int e = 0; e < 4; ++e) acc[n][e] = 0.f;
#pragma unroll 8
    for (int kk = 0; kk < 32; ++kk) { const int k = wave * 32 + kk;
        const f32x4 w = *(const f32x4*)(W + (size_t)k * NMOD);
        const f32x4 s0 = *(const LAS f32x4*)(sil + k * 12), s1 = *(const LAS f32x4*)(sil + k * 12 + 4); const float s8 = sil[k * 12 + 8];
#pragma unroll
        for (int e = 0; e < 4; ++e) { acc[0][e] += s0[0] * w[e]; acc[1][e] += s0[1] * w[e]; acc[2][e] += s0[2] * w[e]; acc[3][e] += s0[3] * w[e];
            acc[4][e] += s1[0] * w[e]; acc[5][e] += s1[1] * w[e]; acc[6][e] += s1[2] * w[e]; acc[7][e] += s1[3] * w[e]; acc[8][e] += s8 * w[e]; } }
#pragma unroll
    for (int s = 4; s >= 1; s >>= 1) {
        if (wave >= s && wave < 2 * s) {
#pragma unroll
            for (int n = 0; n < 9; ++n)
#pragma unroll
                for (int e = 0; e < 4; ++e) red[((wave - s) * 36 + n * 4 + e) * 64 + lane] = acc[n][e]; }
        __syncthreads();
        if (wave < s) {
#pragma unroll
            for (int n = 0; n < 9; ++n)
#pragma unroll
                for (int e = 0; e < 4; ++e) acc[n][e] += red[(wave * 36 + n * 4 + e) * 64 + lane]; }
        __syncthreads();
    }
    if (wave == 0) { const int col = cgp * 256 + lane * 4; f32x4 b = {0.f, 0.f, 0.f, 0.f}; if (kq == 0) b = *(const f32x4*)(bmod + (size_t)l * NMOD + col);
#pragma unroll
        for (int n = 0; n < 9; ++n) { float* dst = mod + ((size_t)l * 9 + n) * NMOD + col;
#pragma unroll
            for (int e = 0; e < 4; ++e) __builtin_amdgcn_global_atomic_fadd_f32((__attribute__((address_space(1))) float*)(dst + e), acc[n][e] + b[e]); } }
    __syncthreads();
}
__device__ __forceinline__ void norm_pass(const float* x0, const float* x1, const float* g, const float* modl, int shk, int sck, bf16_t* H, int gw, int ngw, int lane) {
    for (int rowa = gw; rowa < MTOT; rowa += 2 * ngw) { const int rowb = rowa + ngw < MTOT ? rowa + ngw : rowa;
        const float* xa = rowa < NPR ? x0 + (size_t)rowa * DM : x1 + (size_t)(rowa - NPR) * DM;
        const float* xb = rowb < NPR ? x0 + (size_t)rowb * DM : x1 + (size_t)(rowb - NPR) * DM;
        f32x4 va[8], vb[8]; float sa = 0.f, sb = 0.f;
#pragma unroll
        for (int j = 0; j < 8; ++j) { va[j] = *(const f32x4*)(xa + 4 * (lane + 64 * j)); vb[j] = *(const f32x4*)(xb + 4 * (lane + 64 * j)); }
#pragma unroll
        for (int j = 0; j < 8; ++j) { sa += va[j][0] * va[j][0] + va[j][1] * va[j][1] + va[j][2] * va[j][2] + va[j][3] * va[j][3]; sb += vb[j][0] * vb[j][0] + vb[j][1] * vb[j][1] + vb[j][2] * vb[j][2] + vb[j][3] * vb[j][3]; }
#pragma unroll
        for (int o = 1; o < 64; o <<= 1) { sa += shx(sa, o, lane); sb += shx(sb, o, lane); }
        const float ra = rsqrtf(sa * (1.f / DM) + EPS), rb = rsqrtf(sb * (1.f / DM) + EPS);
        const float* ma = modl + (size_t)(rowa >> 12) * NMOD; const float* mb = modl + (size_t)(rowb >> 12) * NMOD;
#pragma unroll
        for (int j = 0; j < 8; ++j) { const int c = 4 * (lane + 64 * j); const f32x4 gg = *(const f32x4*)(g + c);
            const f32x4 sca = *(const f32x4*)(ma + sck * DM + c), sha = *(const f32x4*)(ma + shk * DM + c), scb = *(const f32x4*)(mb + sck * DM + c), shb = *(const f32x4*)(mb + shk * DM + c);
            const f32x4 oa = (va[j] * ra * gg) * (sca + 1.f) + sha, ob = (vb[j] * rb * gg) * (scb + 1.f) + shb;
            u32x2 wa, wb; wa.x = pkbf(oa[0], oa[1]); wa.y = pkbf(oa[2], oa[3]); wb.x = pkbf(ob[0], ob[1]); wb.y = pkbf(ob[2], ob[3]);
            *(u32x2*)(H + (size_t)rowa * DM + c) = wa; *(u32x2*)(H + (size_t)rowb * DM + c) = wb; }
    }
}
__device__ __forceinline__ void final_norm(float* x, const float* g, int gw, int ngw, int lane, float* dst = nullptr) {
    for (int rowa = gw; rowa < MTOT; rowa += 2 * ngw) { const int rowb = rowa + ngw < MTOT ? rowa + ngw : rowa;
        float* xa = x + (size_t)rowa * DM; float* xb = x + (size_t)rowb * DM; float* da = dst ? dst + (size_t)rowa * DM : xa; float* db = dst ? dst + (size_t)rowb * DM : xb;
        f32x4 va[8], vb[8]; float sa = 0.f, sb = 0.f;
#pragma unroll
        for (int j = 0; j < 8; ++j) { va[j] = *(const f32x4*)(xa + 4 * (lane + 64 * j)); vb[j] = *(const f32x4*)(xb + 4 * (lane + 64 * j)); }
#pragma unroll
        for (int j = 0; j < 8; ++j) { sa += va[j][0] * va[j][0] + va[j][1] * va[j][1] + va[j][2] * va[j][2] + va[j][3] * va[j][3]; sb += vb[j][0] * vb[j][0] + vb[j][1] * vb[j][1] + vb[j][2] * vb[j][2] + vb[j][3] * vb[j][3]; }
#pragma unroll
        for (int o = 1; o < 64; o <<= 1) { sa += shx(sa, o, lane); sb += shx(sb, o, lane); }
        const float ra = rsqrtf(sa * (1.f / DM) + EPS), rb = rsqrtf(sb * (1.f / DM) + EPS);
#pragma unroll
        for (int j = 0; j < 8; ++j) { const int c = 4 * (lane + 64 * j); const f32x4 gg = *(const f32x4*)(g + c);
            *(f32x4*)(da + c) = va[j] * ra * gg; if (rowb != rowa) *(f32x4*)(db + c) = vb[j] * rb * gg; }
    }
}
__device__ __forceinline__ void hgrn_combine(const bf16_t* Of, const bf16_t* Ob, const bf16_t* G, const float* onorm, bf16_t* Y, int gw, int ngw, int lane) {
    const int ch = (lane & 15) * 8; const f32x4 w0 = *(const f32x4*)(onorm + ch), w1 = *(const f32x4*)(onorm + ch + 4);
    for (int row = gw; row < MTOT; row += ngw) { u32x4 ra[4], rb[4], rg[4];
#pragma unroll
        for (int j = 0; j < 4; ++j) { const size_t off = (size_t)row * DM + j * 512 + lane * 8; ra[j] = *(const u32x4*)(Of + off); rb[j] = *(const u32x4*)(Ob + off); rg[j] = *(const u32x4*)(G + off); }
#pragma unroll
        for (int j = 0; j < 4; ++j) { const size_t off = (size_t)row * DM + j * 512 + lane * 8;
            float a[8], b[8], gg[8]; unpack8(ra[j], a); unpack8(rb[j], b); unpack8(rg[j], gg);
            float ss = 0.f;
#pragma unroll
            for (int e = 0; e < 8; ++e) { a[e] += b[e]; ss += a[e] * a[e]; }
            ss += shx(ss, 1, lane); ss += shx(ss, 2, lane); ss += shx(ss, 4, lane); ss += shx(ss, 8, lane);
            const float rstd = rsqrtf(ss * (1.f / 128.f) + EPS);
#pragma unroll
            for (int e = 0; e < 8; ++e) a[e] = a[e] * rstd * (e < 4 ? w0[e] : w1[e - 4]) * (gg[e] * fsigmoid(gg[e]));
            *(u32x4*)(Y + off) = pack8(a); }
    }
}
__device__ __forceinline__ void attn_combine(const bf16_t* O4, const float* lamp, const float* subln, bf16_t* Y, int gw, int ngw, int lane) {
    const float lam_init = 0.8f - 0.6f * expf(-0.3f);
    const float p1 = wave_sum(lamp[lane] * lamp[128 + lane] + lamp[64 + lane] * lamp[192 + lane], lane);
    const float p2 = wave_sum(lamp[256 + lane] * lamp[384 + lane] + lamp[320 + lane] * lamp[448 + lane], lane);
    const float lam = expf(p1) - expf(p2) + lam_init;
    const int e0 = (lane & 31) * 8; const f32x4 w0 = *(const f32x4*)(subln + e0), w1 = *(const f32x4*)(subln + e0 + 4);
    for (int row = gw; row < MTOT; row += ngw) { u32x4 ra[4], rb[4];
#pragma unroll
        for (int j = 0; j < 4; ++j) { const int head = 2 * j + (lane >> 5); const size_t off = (size_t)row * 4096 + head * 512 + e0; ra[j] = *(const u32x4*)(O4 + off); rb[j] = *(const u32x4*)(O4 + off + 256); }
#pragma unroll
        for (int j = 0; j < 4; ++j) { const int head = 2 * j + (lane >> 5);
            float a[8], b[8]; unpack8(ra[j], a); unpack8(rb[j], b);
            float ss = 0.f;
#pragma unroll
            for (int e = 0; e < 8; ++e) { a[e] -= lam * b[e]; ss += a[e] * a[e]; }
            ss += shx(ss, 1, lane); ss += shx(ss, 2, lane); ss += shx(ss, 4, lane); ss += shx(ss, 8, lane); ss += shx(ss, 16, lane);
            const float rstd = rsqrtf(ss * (1.f / 256.f) + EPS) * (1.f - lam_init);
#pragma unroll
            for (int e = 0; e < 8; ++e) a[e] = a[e] * rstd * (e < 4 ? w0[e] : w1[e - 4]);
            *(u32x4*)(Y + (size_t)row * DM + head * 256 + e0) = pack8(a); }
    }
}
__device__ __forceinline__ void rope_pass(bf16_t* Q, bf16_t* KA, const float* tab, int gw, int ngw, int lane, long dsto = 0) {
    for (int task = gw; task < 65536; task += ngw) { const int arr = task >> 15, st = task & 32767, b = st >> 12, t = st & 4095;
        bf16_t* rowp = arr == 0 ? Q + (size_t)(NPR + st) * DM : KA + (size_t)(b * 4608 + t) * DM;
        u32x4 r1[2], r2[2];
#pragma unroll
        for (int i = 0; i < 2; ++i) { const int T = lane + 64 * i, head = T >> 3, ax = (T >> 2) & 1, f0 = (T & 3) * 8; const bf16_t* p1 = rowp + head * 128 + ax * 64 + f0; r1[i] = *(const u32x4*)p1; r2[i] = *(const u32x4*)(p1 + 32); }
#pragma unroll
        for (int i = 0; i < 2; ++i) { const int T = lane + 64 * i, head = T >> 3, ax = (T >> 2) & 1, f0 = (T & 3) * 8, pos = ax ? (t & 63) : (t >> 6);
            bf16_t* p1 = rowp + head * 128 + ax * 64 + f0; float x1[8], x2[8]; unpack8(r1[i], x1); unpack8(r2[i], x2);
            const float* tp = tab + (pos * 32 + f0) * 2; float o1[8], o2[8];
#pragma unroll
            for (int q = 0; q < 4; ++q) { const f32x4 cs = *(const f32x4*)(tp + 4 * q);
                o1[2 * q] = x1[2 * q] * cs[0] - x2[2 * q] * cs[1]; o2[2 * q] = x2[2 * q] * cs[0] + x1[2 * q] * cs[1];
                o1[2 * q + 1] = x1[2 * q + 1] * cs[2] - x2[2 * q + 1] * cs[3]; o2[2 * q + 1] = x2[2 * q + 1] * cs[2] + x1[2 * q + 1] * cs[3]; }
            *(u32x4*)(p1 + dsto) = pack8(o1); *(u32x4*)(p1 + 32 + dsto) = pack8(o2); }
    }
}
__device__ __forceinline__ void cache_convert(const float* ck, const float* cv, bf16_t* KA, bf16_t* VA, int gw, int ngw, int lane) {
    for (int task = gw; task < 4096 * 4; task += ngw) { const int r = task >> 2, part = task & 3, b = r >> 9, p = r & 511;
        const float* src = cv + (size_t)r * DM + part * 512 + lane * 8; bf16_t* dst = VA + (size_t)(b * 4608 + 4096 + p) * DM + part * 512 + lane * 8;
        const f32x4 a = *(const f32x4*)src, c = *(const f32x4*)(src + 4);
        u32x4 w; w.x = pkbf(a[0], a[1]); w.y = pkbf(a[2], a[3]); w.z = pkbf(c[0], c[1]); w.w = pkbf(c[2], c[3]); *(u32x4*)dst = w; }
    for (int r = gw; r < 4096; r += ngw) { const int b = r >> 9, p = r & 511;
        const float* srow = ck + (size_t)r * DM; bf16_t* drow = KA + (size_t)(b * 4608 + 4096 + p) * DM;
#pragma unroll
        for (int i = 0; i < 2; ++i) { const int T = lane + 64 * i, head = T >> 3, ax = (T >> 2) & 1, f0 = (T & 3) * 8;
            const float* s1 = srow + head * 128 + ax * 64 + f0;
            const f32x4 a0 = *(const f32x4*)s1, a1 = *(const f32x4*)(s1 + 4), b0 = *(const f32x4*)(s1 + 32), b1 = *(const f32x4*)(s1 + 36);
            u32x4 w0, w1; w0.x = pkbf(a0[0], b0[0]); w0.y = pkbf(a0[1], b0[1]); w0.z = pkbf(a0[2], b0[2]); w0.w = pkbf(a0[3], b0[3]);
            w1.x = pkbf(a1[0], b1[0]); w1.y = pkbf(a1[1], b1[1]); w1.z = pkbf(a1[2], b1[2]); w1.w = pkbf(a1[3], b1[3]);
            bf16_t* d = drow + head * 128 + ax * 64 + 2 * f0; *(u32x4*)d = w0; *(u32x4*)(d + 8) = w1; } }
}
__device__ __forceinline__ void ffn_fixup(const bf16_t* halo, const float* cw, const float* cbias, bf16_t* A, int gw, int ngw, int lane) {
    for (int task = gw; task < (MTOT / 64) * 2; task += ngw) { const int grp = task >> 1, last = task & 1, row = grp * 64 + (last ? 63 : 0);
        const int seq0 = row < NPR ? (row & ~255) : NPR + ((row - NPR) & ~4095), seqL = row < NPR ? 256 : 4096;
        const bool hasp = row > seq0, hasn = row < seq0 + seqL - 1;
        const bf16_t* hc = halo + (size_t)(grp * 4 + (last ? 3 : 0)) * NUP;
        const bf16_t* hp = last ? halo + (size_t)(grp * 4 + 2) * NUP : halo + (size_t)((grp - 1) * 4 + 3) * NUP;
        const bf16_t* hn = last ? halo + (size_t)((grp + 1) * 4 + 0) * NUP : halo + (size_t)(grp * 4 + 1) * NUP;
        for (int j = 0; j < 11; ++j) { const int cg = j * 512 + lane * 8, cv = DFF + cg;
            float ug[8], uv[8], pg[8], pv[8], ng[8], nv[8]; unpack8(*(const u32x4*)(hc + cg), ug); unpack8(*(const u32x4*)(hc + cv), uv);
#pragma unroll
            for (int e = 0; e < 8; ++e) { pg[e] = 0.f; pv[e] = 0.f; ng[e] = 0.f; nv[e] = 0.f; }
            if (hasp) { unpack8(*(const u32x4*)(hp + cg), pg); unpack8(*(const u32x4*)(hp + cv), pv); }
            if (hasn) { unpack8(*(const u32x4*)(hn + cg), ng); unpack8(*(const u32x4*)(hn + cv), nv); }
            float o[8];
#pragma unroll
            for (int e = 0; e < 8; ++e) { const float gv = cw[cg + e] * pg[e] + cw[NUP + cg + e] * ug[e] + cw[2 * NUP + cg + e] * ng[e] + cbias[cg + e];
                const float vv = cw[cv + e] * pv[e] + cw[NUP + cv + e] * uv[e] + cw[2 * NUP + cv + e] * nv[e] + cbias[cv + e]; o[e] = gv * fsigmoid(gv) * vv; }
            *(u32x4*)(A + (size_t)row * DFF + cg) = pack8(o); }
    }
}

constexpr int SC_LF = 0, SC_SEG = 33792, SC_QT = 35840, SC_KT = 53248, SC_VS = 70656, SC_PL = 107520, SC_ER = 116736;
typedef short v4i16_t __attribute__((ext_vector_type(4)));
__device__ __forceinline__ bf16x8 tr_pair(const LAS unsigned char* p) {
    const v4i16_t a = __builtin_amdgcn_ds_read_tr16_b64_v4i16((LAS v4i16_t*)p), b = __builtin_amdgcn_ds_read_tr16_b64_v4i16((LAS v4i16_t*)(p + 4 * 272));
    return (bf16x8){a[0], a[1], a[2], a[3], b[0], b[1], b[2], b[3]}; }
__device__ __forceinline__ void hgrn_unit(LAS unsigned char* lds, const bf16_t* Qh, const bf16_t* Vh, const bf16_t* LF, bf16_t* Od, const float* S0, float* Sout,
                                          int seqbase, int nch, int h, int dir, int tid, int wave, int lane) {
    int opq = 0; asm volatile("" : "+v"(opq));
    const int g = (lane >> 4) + opq, l16 = lane & 15;
    const int fs = (tid >> 4) + opq, fc = (tid & 15) * 8;
    LAS float* LFs = (LAS float*)(lds + SC_LF); LAS float* SEG = (LAS float*)(lds + SC_SEG);
    LAS float* ER = (LAS float*)(lds + SC_ER); LAS float* EL = ER + 128; LAS float* ELR = ER + 256;
    LAS bf16_t* PL = (LAS bf16_t*)(lds + SC_PL);
    const int trq = (lane & 15) >> 2, trp = lane & 3;
    f32x4 Sacc[8];
#pragma unroll
    for (int mt = 0; mt < 8; ++mt)
#pragma unroll
        for (int i = 0; i < 4; ++i) Sacc[mt][i] = S0 ? S0[(16 * mt + 4 * g + i) * 128 + 16 * wave + l16] : 0.f;
    for (int i = tid; i < 64 * 72 / 2; i += 512) ((LAS unsigned*)(lds + SC_PL))[i] = 0u;
    u32x4 pq[2], pv[2], pl[2];
    { const int c0 = dir ? nch - 1 : 0;
#pragma unroll
      for (int i = 0; i < 2; ++i) { const size_t off = (size_t)(seqbase + 64 * c0 + fs + 32 * i) * DM + h * 128 + fc;
          pq[i] = *(const u32x4*)(Qh + off); pv[i] = *(const u32x4*)(Vh + off); pl[i] = *(const u32x4*)(LF + off); } }
    for (int step = 0; step < nch; ++step) {
        const int cidx = dir ? nch - 1 - step : step; const int R0 = seqbase + 64 * cidx;
        u32x4 cq[2], cv[2], cl[2];
#pragma unroll
        for (int i = 0; i < 2; ++i) { cq[i] = pq[i]; cv[i] = pv[i]; cl[i] = pl[i]; }
#pragma unroll
        for (int i = 0; i < 2; ++i) { LAS float* d = LFs + (fs + 32 * i) * 132 + fc;
            f32x4 a, b; a[0] = f16lo(cl[i].x); a[1] = f16hi(cl[i].x); a[2] = f16lo(cl[i].y); a[3] = f16hi(cl[i].y); b[0] = f16lo(cl[i].z); b[1] = f16hi(cl[i].z); b[2] = f16lo(cl[i].w); b[3] = f16hi(cl[i].w);
            *(LAS f32x4*)d = a; *(LAS f32x4*)(d + 4) = b; }
        if (step + 1 < nch) { const int cn = dir ? cidx - 1 : cidx + 1;
#pragma unroll
            for (int i = 0; i < 2; ++i) { const size_t off = (size_t)(seqbase + 64 * cn + fs + 32 * i) * DM + h * 128 + fc;
                pq[i] = *(const u32x4*)(Qh + off); pv[i] = *(const u32x4*)(Vh + off); pl[i] = *(const u32x4*)(LF + off); } }
        lds_barrier();
        { const int c = tid & 127, seg = tid >> 7; float v[16];
#pragma unroll
          for (int r = 0; r < 16; ++r) v[r] = LFs[(16 * seg + (dir ? 15 - r : r)) * 132 + c];
#pragma unroll
          for (int r = 1; r < 16; ++r) v[r] += v[r - 1];
#pragma unroll
          for (int r = 0; r < 16; ++r) LFs[(16 * seg + (dir ? 15 - r : r)) * 132 + c] = v[r];
          SEG[seg * 128 + c] = v[15]; }
        lds_barrier();
        { const bool hiseg = (fs >> 4) != 0; const int mr = dir ? 32 : 31, lr = dir ? 0 : 63;
#pragma unroll
          for (int hf = 0; hf < 2; ++hf) { const int c4 = fc + 4 * hf;
              const f32x4 T0 = *(const LAS f32x4*)(SEG + c4), T1 = *(const LAS f32x4*)(SEG + 128 + c4), T2 = *(const LAS f32x4*)(SEG + 256 + c4), T3 = *(const LAS f32x4*)(SEG + 384 + c4);
              const f32x4 z4 = {0.f, 0.f, 0.f, 0.f}; f32x4 om, ol, o0, o1;
              if (!dir) { om = T0; ol = T0 + T1 + T2; o0 = hiseg ? T0 : z4; o1 = T0 + T1 + (hiseg ? T2 : z4); }
              else { om = T3; ol = T3 + T2 + T1; o1 = hiseg ? z4 : T3; o0 = T3 + T2 + (hiseg ? z4 : T1); }
              const f32x4 rr = *(const LAS f32x4*)(LFs + mr * 132 + c4) + om;
              if (fs == 0) { const f32x4 bl = *(const LAS f32x4*)(LFs + lr * 132 + c4) + ol;
#pragma unroll
                  for (int e = 0; e < 4; ++e) { ER[c4 + e] = __builtin_amdgcn_exp2f(rr[e]); EL[c4 + e] = __builtin_amdgcn_exp2f(bl[e]); ELR[c4 + e] = __builtin_amdgcn_exp2f(bl[e] - rr[e]); } }
#pragma unroll
              for (int i = 0; i < 2; ++i) { const int s = fs + 32 * i;
                  const f32x4 bb = *(const LAS f32x4*)(LFs + s * 132 + c4) + (i ? o1 : o0);
                  const unsigned qw0 = hf ? cq[i].z : cq[i].x, qw1 = hf ? cq[i].w : cq[i].y, vw0 = hf ? cv[i].z : cv[i].x, vw1 = hf ? cv[i].w : cv[i].y, lw0 = hf ? cl[i].z : cl[i].x, lw1 = hf ? cl[i].w : cl[i].y;
                  const float q[4] = {bflo(qw0), bfhi(qw0), bflo(qw1), bfhi(qw1)}; const float lf[4] = {f16lo(lw0), f16hi(lw0), f16lo(lw1), f16hi(lw1)};
                  const f32x4 d4 = bb - rr, q4 = {q[0], q[1], q[2], q[3]}; f32x4 ep, en, fv;
#pragma unroll
                  for (int e = 0; e < 4; ++e) { const float d = fminf(fmaxf(d4[e], -115.f), 115.f); ep[e] = __builtin_amdgcn_exp2f(d); en[e] = __builtin_amdgcn_exp2f(-d); fv[e] = __builtin_amdgcn_exp2f(lf[e]); }
                  const f32x4 qt = q4 * ep, kt = en - fv * en;
                  u32x2 qw, kw; qw.x = pkbf(qt[0], qt[1]); qw.y = pkbf(qt[2], qt[3]); kw.x = pkbf(kt[0], kt[1]); kw.y = pkbf(kt[2], kt[3]);
                  *(LAS u32x2*)(lds + SC_QT + s * 272 + c4 * 2) = qw; *(LAS u32x2*)(lds + SC_KT + s * 272 + c4 * 2) = kw;
                  u32x2 vw; vw.x = vw0; vw.y = vw1; *(LAS u32x2*)(lds + SC_VS + s * 272 + c4 * 2) = vw; }
              asm volatile("" ::: "memory"); }
        }
        lds_barrier();
        for (int ti_ = wave; ti_ < 10; ti_ += 8) {
            int ti, sj; { int a = ti_ < 1 ? 0 : ti_ < 3 ? 1 : ti_ < 6 ? 2 : 3; int b = ti_ - (a * (a + 1)) / 2; if (!dir) { ti = a; sj = b; } else { ti = 3 - a; sj = 3 - b; } }
            f32x4 p = {0.f, 0.f, 0.f, 0.f};
#pragma unroll
            for (int kk = 0; kk < 4; ++kk) { const bf16x8 xa = *(const LAS bf16x8*)(lds + SC_QT + (16 * ti + l16) * 272 + 64 * kk + 16 * g);
                const bf16x8 yb = *(const LAS bf16x8*)(lds + SC_KT + (16 * sj + l16) * 272 + 64 * kk + 16 * g);
                p = __builtin_amdgcn_mfma_f32_16x16x32_bf16(xa, yb, p, 0, 0, 0); }
#pragma unroll
            for (int i = 0; i < 4; ++i) { const int t = 16 * ti + 4 * g + i, s = 16 * sj + l16; const bool keep = dir ? (s >= t) : (s <= t);
                PL[t * 72 + s] = (bf16_t)(pkbf(keep ? p[i] : 0.f, 0.f) & 0xffffu); }
        }
        asm volatile("" ::: "memory");
        f32x4 oacc[4];
#pragma unroll
        for (int ti = 0; ti < 4; ++ti) oacc[ti] = (f32x4){0.f, 0.f, 0.f, 0.f};
#pragma unroll
        for (int kk = 0; kk < 4; ++kk) {
            const f32x4 e0 = *(const LAS f32x4*)(ER + 32 * kk + 4 * g), e1 = *(const LAS f32x4*)(ER + 32 * kk + 16 + 4 * g);
            const f32x4 s0 = Sacc[2 * kk] * e0, s1 = Sacc[2 * kk + 1] * e1;
            u32x4 yw; yw.x = pkbf(s0[0], s0[1]); yw.y = pkbf(s0[2], s0[3]); yw.z = pkbf(s1[0], s1[1]); yw.w = pkbf(s1[2], s1[3]);
            const bf16x8 yb = __builtin_bit_cast(bf16x8, yw);
#pragma unroll
            for (int ti = 0; ti < 4; ++ti) { const LAS unsigned char* qp = lds + SC_QT + (16 * ti + l16) * 272 + 64 * kk + 8 * g;
                const u32x2 a0 = *(const LAS u32x2*)qp, a1 = *(const LAS u32x2*)(qp + 32);
                u32x4 xw; xw.x = a0.x; xw.y = a0.y; xw.z = a1.x; xw.w = a1.y;
                oacc[ti] = __builtin_amdgcn_mfma_f32_16x16x32_bf16(__builtin_bit_cast(bf16x8, xw), yb, oacc[ti], 0, 0, 0); }
            asm volatile("" ::: "memory");
        }
        bf16x8 vb[2];
#pragma unroll
        for (int ks = 0; ks < 2; ++ks) vb[ks] = tr_pair(lds + SC_VS + (32 * ks + 8 * g + trq) * 272 + (16 * wave + 4 * trp) * 2);
#pragma unroll
        for (int mt = 0; mt < 8; ++mt) { f32x4 d = {0.f, 0.f, 0.f, 0.f};
#pragma unroll
            for (int ks = 0; ks < 2; ++ks) { const bf16x8 xa = tr_pair(lds + SC_KT + (32 * ks + 8 * g + trq) * 272 + (16 * mt + 4 * trp) * 2);
                d = __builtin_amdgcn_mfma_f32_16x16x32_bf16(xa, vb[ks], d, 0, 0, 0); }
            const f32x4 el = *(const LAS f32x4*)(EL + 16 * mt + 4 * g), elr = *(const LAS f32x4*)(ELR + 16 * mt + 4 * g);
            Sacc[mt] = el * Sacc[mt] + elr * d; asm volatile("" ::: "memory"); }
        lds_barrier();
#pragma unroll
        for (int ti = 0; ti < 4; ++ti)
#pragma unroll
            for (int ks = 0; ks < 2; ++ks) { const bf16x8 xa = *(const LAS bf16x8*)(lds + SC_PL + (16 * ti + l16) * 144 + 64 * ks + 16 * g);
                oacc[ti] = __builtin_amdgcn_mfma_f32_16x16x32_bf16(xa, vb[ks], oacc[ti], 0, 0, 0); }
#pragma unroll
        for (int ti = 0; ti < 4; ++ti)
#pragma unroll
            for (int i = 0; i < 4; ++i) Od[(size_t)(R0 + 16 * ti + 4 * g + i) * DM + h * 128 + 16 * wave + l16] = (bf16_t)(pkbf(oacc[ti][i], 0.f) & 0xffffu);
    }
    if (Sout) { int opq2 = 0; asm volatile("" : "+v"(opq2)); Sout += opq2;
#pragma unroll
        for (int mt = 0; mt < 8; ++mt)
#pragma unroll
            for (int i = 0; i < 4; ++i) Sout[(16 * mt + 4 * g + i) * 128 + 16 * wave + l16] = Sacc[mt][i]; }
    __syncthreads();
}


#define XB_TMO      128
#define XB_XCNT(j)  (256  + 64 * (j))
#define XB_XSUB(j)  (1280 + 64 * (j))
#define XB_XGEN(j)  (2304 + 64 * (j))
#define XB_TOP      3328
#define XB_TOPGEN   3392
#define XCD_BAR_WORDS 3456
#define XB_SPIN_CAP (1u << 18)

__device__ __forceinline__ unsigned xb_ld(unsigned* p)              { return __hip_atomic_load(p, __ATOMIC_RELAXED, __HIP_MEMORY_SCOPE_AGENT); }
__device__ __forceinline__ unsigned xb_add(unsigned* p, unsigned v) { return __hip_atomic_fetch_add(p, v, __ATOMIC_RELAXED, __HIP_MEMORY_SCOPE_AGENT); }
__device__ __forceinline__ unsigned xb_xcc_id() { return (unsigned)__builtin_amdgcn_s_getreg((3 << 11) | 20) & 0xFu; }
#define XB_SPIN(cond, bar) do { unsigned _sp = 0; while (cond) { __builtin_amdgcn_s_sleep(1); \
    if ((++_sp & 255u) == 0u) { if (xb_ld(&(bar)[XB_TMO])) break; if (_sp > XB_SPIN_CAP) { atomicAdd(&(bar)[XB_TMO], 1u); break; } } } } while (0)

struct XcdBarrier {
    unsigned* bar; unsigned x;
    volatile LAS unsigned* st;
};

__device__ __forceinline__ XcdBarrier xcd_barrier_post(unsigned* bar, volatile LAS unsigned* st) {
    XcdBarrier b; b.bar = bar; b.x = xb_xcc_id(); b.st = st;
    if (threadIdx.x == 0) (void)xb_add(&bar[XB_XCNT(b.x)], 1u);
    return b;
}
__device__ __forceinline__ void xcd_barrier_complete(unsigned* bar, unsigned x, unsigned& nloc, unsigned& nx) {
    const unsigned G = gridDim.x * gridDim.y * gridDim.z;
    unsigned sum, cnt, mine, sp = 0u;
    for (;;) {
        sum = 0u; cnt = 0u; mine = 0u;
#pragma unroll
        for (unsigned j = 0; j < 16; ++j) { const unsigned c = xb_ld(&bar[XB_XCNT(j)]); sum += c; cnt += (c > 0u) ? 1u : 0u; mine = (j == x) ? c : mine; }
        if (sum == G) break;
        __builtin_amdgcn_s_sleep(1);
        if ((++sp & 255u) == 0u) { if (xb_ld(&bar[XB_TMO])) break; if (sp > XB_SPIN_CAP) { atomicAdd(&bar[XB_TMO], 1u); break; } }
    }
    nloc = mine > 0u ? mine : 1u; nx = cnt > 0u ? cnt : 1u;
}

__device__ __forceinline__ void xcd_barrier(const XcdBarrier& b) {
    asm volatile("s_waitcnt vmcnt(0)" ::: "memory");
    __syncthreads();
    if (threadIdx.x == 0) {
        unsigned* bar = b.bar;
        __builtin_amdgcn_s_waitcnt(0);
        unsigned nloc = b.st[0], nx = b.st[1];
        if (nloc == 0u) { xcd_barrier_complete(bar, b.x, nloc, nx); b.st[0] = nloc; b.st[1] = nx; }
        const unsigned old = xb_add(&bar[XB_XSUB(b.x)], 1u);
        const unsigned gen = old / nloc;
        if (old + 1u == (gen + 1u) * nloc) {
            __builtin_amdgcn_fence(__ATOMIC_RELEASE, "agent");
            asm volatile("s_waitcnt vmcnt(0)" ::: "memory");
            const unsigned og = xb_add(&bar[XB_TOP], 1u);
            const unsigned tg = og / nx;
            if (og + 1u == (tg + 1u) * nx) xb_add(&bar[XB_TOPGEN], 1u);
            else XB_SPIN(xb_ld(&bar[XB_TOPGEN]) == tg, bar);
            __builtin_amdgcn_fence(__ATOMIC_ACQUIRE, "agent");
            xb_add(&bar[XB_XGEN(b.x)], 1u);
            asm volatile("s_waitcnt vmcnt(0)" ::: "memory");
        } else {
            XB_SPIN(xb_ld(&bar[XB_XGEN(b.x)]) == gen, bar);
            __builtin_amdgcn_fence(__ATOMIC_ACQUIRE, "agent");
            asm volatile("s_waitcnt vmcnt(0)" ::: "memory");
        }
    }
    __syncthreads();
}

struct Args { const float* in[24]; float* out; unsigned char* ws; int ph_lo, ph_hi; };
typedef __attribute__((address_space(4))) const unsigned char* kargp_t;
__device__ __forceinline__ const float* KIN(int k) { int z = 0; asm volatile("" : "+s"(z)); kargp_t kp = (kargp_t)__builtin_amdgcn_kernarg_segment_ptr(); return *(const float* const __attribute__((address_space(4)))*)(kp + (size_t)(k + z) * 8); }
__device__ __forceinline__ float* KOUT() { return (float*)KIN(24); }
__device__ __forceinline__ unsigned char* KWS() { return (unsigned char*)KIN(25); }
#define PH_SG int G = gridDim.x, bx = blockIdx.x; asm volatile("" : "+s"(G), "+s"(bx)); const int ngw = G * 8; (void)ngw;
#define PH_IDS PH_SG int tid = threadIdx.x; asm volatile("" : "+v"(tid)); const int lane = tid & 63, wave = __builtin_amdgcn_readfirstlane(tid >> 6); const int gw = bx * 8 + wave; (void)lane; (void)gw;
__global__ void __launch_bounds__(512, 2) mega_fwd(Args a) {
    extern __shared__ __attribute__((aligned(16))) unsigned char lds_[];
    LAS unsigned char* lds = (LAS unsigned char*)lds_;
    cg::grid_group grid = cg::this_grid();
    volatile LAS unsigned* xst = (volatile LAS unsigned*)(lds + LDS_BYTES - 64);
    if (threadIdx.x == 0) { xst[0] = 0u; xst[1] = 0u; }
    __syncthreads();
    XcdBarrier xbar = xcd_barrier_post((unsigned*)(KWS() + WS_BAR), xst);
    bool first_seam = true;
#ifndef PROBE_DUP
#define PROBE_DUP_ 0u
#else
#define PROBE_DUP_ PROBE_DUP
#endif
#ifndef MK_SPLIT
#define MK_SPLIT 0
#endif
#ifndef PH_MASK
#define PH_MASK 0xFFFFFFFFu
#endif
#if MK_SPLIT
    const int ph_lo = a.ph_lo, ph_hi = a.ph_hi; int ph = 0;
#define RUNB(b) (((PH_MASK >> (b)) & 1u) && ph >= ph_lo && ph < ph_hi)
#define SEAM() do { if (ph >= ph_lo && ph + 1 < ph_hi) grid.sync(); ++ph; } while (0)
#else
    (void)a;
#define RUNB(b) ((PH_MASK >> (b)) & 1u)
#define SEAM() do { if (first_seam) { grid.sync(); first_seam = false; } else xcd_barrier(xbar); if ((PROBE_DUP_ >> 10) & 1u) xcd_barrier(xbar); } while (0)
#endif
#define RUN() RUNB(1)
#ifndef PROBE_DUP
#define PROBE_DUP 0u
#endif
#define REP(k) for (int rep_ = 0; rep_ < (((PROBE_DUP >> (k)) & 1u) ? 2 : 1); ++rep_)
#define WSP(off) ((bf16_t*)(KWS() + (off)))

    if (RUNB(0)) REP(3) { PH_IDS
        unsigned char* ws = KWS();
        for (int task = bx; task < 768; task += G) mod_task(task, KIN(2), KIN(6), KIN(7), KIN(8), (float*)(ws + WS_MOD), lds, tid, wave, lane);
        if (bx == G - 1) { float* lbt = (float*)(ws + WS_LB); float* ropet = (float*)(ws + WS_ROPE); const float* lg = KIN(12);
            for (int i = tid; i < 2 * DM; i += 512) { const int d = i / DM, c = i % DM; const float l0 = lg[(d * 2 + 0) * DM + c], l1 = lg[(d * 2 + 1) * DM + c]; lbt[i] = 1.f / (1.f + expf(l1 - l0)); }
            for (int i = tid; i < 2048; i += 512) { const int pos = i >> 5, f = i & 31; const float inv = powf(10000.f, -(float)f / 32.f); const float ang = (float)pos * inv; ropet[2 * i] = cosf(ang); ropet[2 * i + 1] = sinf(ang); }
        }
    }
    SEAM();
    for (int l = 0; l < 2; ++l) {
        if (RUN()) REP(4) { PH_IDS
            unsigned char* ws = KWS(); const float* modl = (const float*)(ws + WS_MOD) + (size_t)l * 9 * NMOD; float* out = KOUT();
            if (l == 0) norm_pass(KIN(0), KIN(1), KIN(9), modl, 0, 1, (bf16_t*)(ws + WS_H), gw, ngw, lane);
            else norm_pass(out, out + (size_t)NPR * DM, KIN(9) + DM, modl, 0, 1, (bf16_t*)(ws + WS_H), gw, ngw, lane);
            transpose_layer(l, ws, lds, gw, ngw, wave, lane);
            if (l == 1) cache_convert(KIN(4), KIN(5), (bf16_t*)(ws + WS_B0) + SZ / 2, (bf16_t*)(ws + WS_B0) + SZ, gw, ngw, lane);
        }
        SEAM();
        if (l == 0) {
            if (RUNB(2)) REP(0) { PH_SG unsigned char* ws = KWS(); pg8::Gemm g{(bf16_t*)(ws + WS_H), (bf16_t*)(ws + WS_WIN), MTOT, 10240, DM}; pg8::StaticOrder S; S.init(MTOT, 10240, G, bx);
                EpiHgrnIn E{(bf16_t*)(ws + WS_B0), (const float*)(ws + WS_LB)};
                pg8::gemm_phase<EpiHgrnIn, pg8::StaticOrder, true, true>(lds, g, S, E); }
            SEAM();
            if (RUNB(3)) REP(1) { PH_IDS
                for (int u = bx; u < 768; u += G) {
                    bf16_t* B0 = WSP(WS_B0); float* out = KOUT();
                    int b, h, dir, seqbase, nch; const float* S0 = nullptr; float* So = nullptr;
                    if (u < 256) { b = u >> 5; h = (u >> 1) & 15; dir = u & 1; seqbase = NPR + b * 4096; nch = 64; S0 = KIN(3) + ((size_t)(b * 2 + dir) * 16 + h) * 16384; }
                    else { const int p = u - 256; b = p >> 5; h = (p >> 1) & 15; dir = p & 1; seqbase = b * 256; nch = 4; So = out + OUT_STATE + ((size_t)(b * 2 + dir) * 16 + h) * 16384; }
                    hgrn_unit(lds, B0, B0 + 3 * (SZ / 2), B0 + (size_t)(1 + dir) * (SZ / 2), (bf16_t*)out + (size_t)dir * MTOT * DM, S0, So, seqbase, nch, h, dir, tid, wave, lane);
                }
            }
            SEAM();
            if (RUN()) REP(7) { PH_IDS bf16_t* B0 = WSP(WS_B0); float* out = KOUT(); hgrn_combine((bf16_t*)out, (bf16_t*)out + (size_t)MTOT * DM, B0 + 2 * SZ, KIN(13), WSP(WS_H), gw, ngw, lane); }
            SEAM();
            if (RUNB(4)) { PH_SG unsigned char* ws = KWS(); pg8::Gemm g{(bf16_t*)(ws + WS_H), (bf16_t*)(ws + WS_WOUT), MTOT, DM, DM}; pg8::StaticOrder S; S.init(MTOT, DM, G, bx);
                EpiResid E{KIN(0), KIN(1), KOUT(), (const float*)(ws + WS_MOD) + 2 * DM};
                pg8::gemm_phase<EpiResid, pg8::StaticOrder, true, true>(lds, g, S, E); }
            SEAM();
        } else {
            if (RUNB(5)) REP(6) { PH_SG unsigned char* ws = KWS(); bf16_t* B0 = (bf16_t*)(ws + WS_B0); float* out = KOUT();
                pg8::Gemm g{(bf16_t*)(ws + WS_H), (bf16_t*)(ws + WS_WIN), MTOT, 6144, DM}; pg8::StaticOrder S; S.init(MTOT, 6144, G, bx);
                EpiAttnIn E{B0, B0 + SZ / 2, B0 + SZ, B0 + 3 * (SZ / 2), B0 + 3 * (SZ / 2) + (size_t)NPR * DM, out + OUT_NK, out + OUT_NV, (const float*)(ws + WS_ROPE)};
                pg8::gemm_phase<EpiAttnIn, pg8::StaticOrder, true, true>(lds, g, S, E); }
            SEAM();
            if (RUNB(6)) REP(2) { PH_SG
                const int vcu = (G % 8 == 0) ? (bx % 8) * (G / 8) + bx / 8 : bx;
                for (int uu = vcu; uu < 4608; uu += G) {
                    bf16_t* B0 = WSP(WS_B0); bf16_t *Qa = B0, *KA = B0 + SZ / 2, *VA = B0 + SZ, *KP = B0 + 3 * (SZ / 2), *VP = KP + (size_t)NPR * DM, *O4 = VP + (size_t)NPR * DM;
                    const att::bf16 *qp, *kp, *vp; att::bf16* op; int seq;
                    if (uu < 4096) { const int qb = uu & 15, half = (uu >> 4) & 1, j = (uu >> 5) & 15, b = uu >> 9; const size_t row = NPR + (size_t)b * 4096 + qb * 256;
                        qp = (const att::bf16*)(Qa + row * DM + j * 128); kp = (const att::bf16*)(KA + (size_t)b * 4608 * DM + j * 128);
                        vp = (const att::bf16*)(VA + (size_t)b * 4608 * DM + (j >> 1) * 256 + half * 128); op = (att::bf16*)(O4 + row * 4096 + (j >> 1) * 512 + (j & 1) * 256 + half * 128); seq = 4608; }
                    else { const int p = uu - 4096, half = p & 1, j = (p >> 1) & 15, b = p >> 5; const size_t row = (size_t)b * 256;
                        qp = (const att::bf16*)(Qa + row * DM + j * 128); kp = (const att::bf16*)(KP + row * DM + j * 128);
                        vp = (const att::bf16*)(VP + row * DM + (j >> 1) * 256 + half * 128); op = (att::bf16*)(O4 + row * 4096 + (j >> 1) * 512 + (j & 1) * 256 + half * 128); seq = 256; }
                    att::attn_dense_body<att::bf16>(qp, kp, vp, op, seq, (char*)lds_);
                    __syncthreads();
                }
            }
            SEAM();
            if (RUN()) REP(7) { PH_IDS bf16_t* B0 = WSP(WS_B0); attn_combine(B0 + 3 * (SZ / 2) + 2 * (size_t)NPR * DM, KIN(16), KIN(17), WSP(WS_H), gw, ngw, lane); }
            SEAM();
            if (RUNB(4)) { PH_SG unsigned char* ws = KWS(); float* out = KOUT(); pg8::Gemm g{(bf16_t*)(ws + WS_H), (bf16_t*)(ws + WS_WOUT), MTOT, DM, DM}; pg8::StaticOrder S; S.init(MTOT, DM, G, bx);
                EpiResid E{out, out + (size_t)NPR * DM, out, (const float*)(ws + WS_MOD) + 9 * NMOD + 2 * DM};
                pg8::gemm_phase<EpiResid, pg8::StaticOrder, true, true>(lds, g, S, E); }
            SEAM();
        }
        if (RUN()) REP(4) { PH_IDS unsigned char* ws = KWS(); float* out = KOUT(); norm_pass(out, out + (size_t)NPR * DM, KIN(10) + l * DM, (const float*)(ws + WS_MOD) + (size_t)l * 9 * NMOD, 3, 4, (bf16_t*)(ws + WS_H), gw, ngw, lane); }
        SEAM();
        if (RUNB(7)) REP(5) { PH_SG unsigned char* ws = KWS(); bf16_t* B0 = (bf16_t*)(ws + WS_B0);
            pg8::Gemm g{(bf16_t*)(ws + WS_H), (bf16_t*)(ws + WS_WUP), MTOT, NUP, DM}; pg8::StaticOrder S; S.init(MTOT, NUP, G, bx);
            EpiFfnUp E{B0, B0 + (size_t)MTOT * DFF, KIN(20) + (size_t)l * 3 * NUP, KIN(21) + (size_t)l * NUP};
            pg8::gemm_phase<EpiFfnUp, pg8::StaticOrder, true, true>(lds, g, S, E); }
        SEAM();
        if (RUN()) REP(8) { PH_IDS bf16_t* B0 = WSP(WS_B0); ffn_fixup(B0 + (size_t)MTOT * DFF, KIN(20) + (size_t)l * 3 * NUP, KIN(21) + (size_t)l * NUP, B0, gw, ngw, lane); }
        SEAM();
        if (RUNB(4)) { PH_SG unsigned char* ws = KWS(); float* out = KOUT(); pg8::Gemm g{(bf16_t*)(ws + WS_B0), (bf16_t*)(ws + WS_WDOWN), MTOT, DM, DFF}; pg8::StaticOrder S; S.init(MTOT, DM, G, bx);
            EpiResid E{out, out + (size_t)NPR * DM, out, (const float*)(ws + WS_MOD) + (size_t)l * 9 * NMOD + 5 * DM};
            pg8::gemm_phase<EpiResid, pg8::StaticOrder, true, true>(lds, g, S, E); }
        SEAM();
    }
    if ((PROBE_DUP >> 12) & 1u) { PH_IDS final_norm(KOUT(), KIN(23), gw, ngw, lane, (float*)(KWS() + WS_B0)); }
    if (RUN()) { PH_IDS final_norm(KOUT(), KIN(23), gw, ngw, lane); }
#undef RUN
#undef RUNB
#undef SEAM
}

constexpr int N_PHASES = 21;
extern "C" void kernel_launch(void* const* d_in, const int* in_sizes, int n_in, void* d_out, int out_size, void* d_ws, size_t ws_size, hipStream_t stream) {
    static int grid = 0;
    if (grid == 0) {
        if (n_in != 24 || ws_size < WS_END) { fprintf(stderr, "kernel_launch: unexpected n_in %d or ws_size %zu (< %zu)\n", n_in, ws_size, (size_t)WS_END); grid = -1; return; }
        int dev = 0, cus = 0, per_cu = 0;
        hipGetDevice(&dev); hipDeviceGetAttribute(&cus, hipDeviceAttributeMultiprocessorCount, dev);
        if (hipFuncSetAttribute((const void*)mega_fwd, hipFuncAttributeMaxDynamicSharedMemorySize, LDS_BYTES) != hipSuccess) { fprintf(stderr, "kernel_launch: hipFuncSetAttribute failed\n"); grid = -1; return; }
        if (hipOccupancyMaxActiveBlocksPerMultiprocessor(&per_cu, (const void*)mega_fwd, 512, LDS_BYTES) != hipSuccess || per_cu < 1) { fprintf(stderr, "kernel_launch: occupancy query says %d\n", per_cu); per_cu = 1; }
        (void)hipGetLastError();
        grid = cus * (per_cu > 1 ? 1 : per_cu);
        if (grid <= 0) grid = 256;
    }
    if (grid < 0) return;
    if (hipMemsetAsync((char*)d_ws, 0, WS_BAR + BAR_BYTES, stream) != hipSuccess) { fprintf(stderr, "kernel_launch: memset failed\n"); return; }
    Args a{};
    for (int i = 0; i < 24; ++i) a.in[i] = (const float*)d_in[i];
    a.out = (float*)d_out; a.ws = (unsigned char*)d_ws;
#if MK_SPLIT
    for (int p = 0; p < N_PHASES; ++p) { a.ph_lo = p; a.ph_hi = p + 1; void* args[] = {&a};
        hipError_t e = hipLaunchCooperativeKernel((const void*)mega_fwd, dim3(grid), dim3(512), args, LDS_BYTES, stream);
        if (e != hipSuccess) { fprintf(stderr, "launch %d failed: %s\n", p, hipGetErrorString(e)); break; } }
#else
    a.ph_lo = 0; a.ph_hi = N_PHASES;
    void* args[] = {&a};
    hipError_t e = hipLaunchCooperativeKernel((const void*)mega_fwd, dim3(grid), dim3(512), args, LDS_BYTES, stream);
    if (e != hipSuccess) fprintf(stderr, "cooperative launch failed: %s (grid %d)\n", hipGetErrorString(e), grid);
#endif
}
```

```cpp
#include <hip/hip_runtime.h>
#include <hip/hip_bf16.h>
#include <hip/hip_cooperative_groups.h>
#include <cstdio>
#include <cstdint>
namespace cg = cooperative_groups;
namespace pg8 {
#define PG8_LAS __attribute__((address_space(3)))
typedef unsigned short bf16_t;
typedef short bf16x8 __attribute__((ext_vector_type(8)));
typedef float f32x4 __attribute__((ext_vector_type(4)));
typedef unsigned u32x4 __attribute__((ext_vector_type(4)));
constexpr int BM = 256, BK = 64, HALF = 128, HTB = HALF * BK * 2  , STAGE_BYTES = 8 * HTB, NXCD = 8, WGM = 4;

__host__ __device__ __forceinline__ int lds_byte(int r, int c) { const int st = (r >> 4) * 2 + (c >> 5), rr = r & 15, cc = c & 31, ob = rr * 64 + cc * 2; return st * 1024 + (ob ^ (((ob >> 9) & 1) << 5)); }
__host__ __device__ __forceinline__ void stage_rc(int b, int& R, int& C) { const int st = b / 1024, sb = b % 1024, swz = sb ^ (((sb >> 9) & 1) << 5); R = (st >> 1) * 16 + swz / 64; C = (st & 1) * 32 + (swz % 64) / 2; }
__host__ __device__ __forceinline__ int perm32(int rho) { const int n = rho >> 4, i = rho & 15; return 8 * (i >> 2) + 4 * n + (i & 3); }

struct Unit { int pm, pn; };
struct Gemm { const bf16_t* A; const bf16_t* Bt; int M, N, K; };

struct StaticOrder {
    int nM, nN, nwg, G, c;
    __host__ __device__ void init(int M, int N, int G_, int c_) { nM = M / BM; nN = N / BM; nwg = nM * nN; G = G_; c = c_; }
    __host__ __device__ bool next(int i, Unit& u) const {
        const long L = (long)i * G + c; if (L >= nwg) return false;
        int wgid = (int)L; { const int q = nwg / NXCD, r = nwg % NXCD, xcd = wgid % NXCD, off = wgid / NXCD; wgid = (xcd < r ? xcd * (q + 1) : r * (q + 1) + (xcd - r) * q) + off; }
        const int nig = WGM * nN, gid = wgid / nig, fm = gid * WGM, gsz = (nM - fm) < WGM ? (nM - fm) : WGM;
        u.pm = fm + ((wgid % nig) % gsz); u.pn = (wgid % nig) / gsz; return true;
    }
    __device__ __forceinline__ void a_ready(const Unit&) const {}
    __device__ __forceinline__ void done(const Unit&) const {}
};

__device__ __forceinline__ unsigned cvt_pk_bf16(float lo, float hi) { unsigned r; asm volatile("v_cvt_pk_bf16_f32 %0, %1, %2" : "=v"(r) : "v"(lo), "v"(hi)); return r; }
template <class Epi, class Sched, bool ALIGN_EPI = false, bool SP2 = false>
__device__ __forceinline__ void gemm_phase(PG8_LAS unsigned char* lds, const Gemm g, const Sched& S, const Epi& E) {
    int tid_ = threadIdx.x; asm volatile("" : "+v"(tid_));
    const int tid = tid_, wid = __builtin_amdgcn_readfirstlane(tid >> 6), lane = tid & 63, wr = wid >> 2, wc = wid & 3, fr = lane & 15, fq = lane >> 4;
    const int K = g.K, nt = K / BK;
    unsigned voffA[2], voffB[2];
#pragma unroll
    for (int i = 0; i < 2; ++i) { int R, C; stage_rc(tid * 16 + i * 8192, R, C); const int Rb = Epi::PERM ? ((R & ~31) + perm32(R & 31)) : R;
        voffA[i] = (unsigned)(R * K + C) * 2u; voffB[i] = (unsigned)(Rb * K + C) * 2u; }
    const size_t kstep = (size_t)(BK * 2);
    const size_t hstep = (size_t)HALF * K * 2;
    const size_t tstep = 2 * hstep;
    const unsigned ldsw = (unsigned)wid * 1024u;
    const int aoff = lds_byte(wr * 64 + fr, fq * 8), boff = lds_byte(wc * 32 + fr, fq * 8);
#define PG8_SA(b, h) (((b) * 2 + (h)) * HTB)
#define PG8_SB(b, h) ((4 + (b) * 2 + (h)) * HTB)
#define PG8_STAGE(bufoff, gbase, voff) do { _Pragma("unroll") for (int _i = 0; _i < 2; ++_i) \
        __builtin_amdgcn_global_load_lds((const unsigned*)((const char*)(gbase) + (voff)[_i]), (PG8_LAS unsigned*)(lds + (bufoff) + ldsw + _i * 8192), 16, 0, 0); } while (0)
#define PG8_LDA(dst, b, h) do { _Pragma("unroll") for (int m = 0; m < 4; ++m) _Pragma("unroll") for (int k = 0; k < 2; ++k) dst[m][k] = *(const PG8_LAS bf16x8*)(lds + PG8_SA(b, h) + aoff + m * 2048 + k * 1024); } while (0)
#define PG8_LDB(dst, b, h) do { _Pragma("unroll") for (int n = 0; n < 2; ++n) _Pragma("unroll") for (int k = 0; k < 2; ++k) dst[n][k] = *(const PG8_LAS bf16x8*)(lds + PG8_SB(b, h) + boff + n * 2048 + k * 1024); } while (0)
#define PG8_MMA(ai, bj, At, Bt) do { __builtin_amdgcn_s_setprio(1); _Pragma("unroll") for (int m = 0; m < 4; ++m) _Pragma("unroll") for (int n = 0; n < 2; ++n) _Pragma("unroll") for (int k = 0; k < 2; ++k) \
        acc[ai][bj][m][n] = __builtin_amdgcn_mfma_f32_16x16x32_bf16(Bt[n][k], At[m][k], acc[ai][bj][m][n], 0, 0, 0); __builtin_amdgcn_s_setprio(0); } while (0)
#define PG8_WAIT_V(n) asm volatile("s_waitcnt vmcnt(" #n ")" ::: "memory")
#define PG8_WAIT_L(n) asm volatile("s_waitcnt lgkmcnt(" #n ")" ::: "memory")
#define PG8_BAR __builtin_amdgcn_s_barrier()
#define PG8_SCHED __builtin_amdgcn_sched_barrier(0)
    Unit cur, nxt; int ui = 0;
    if (!S.next(0, cur)) return;
    f32x4 acc[2][2][4][2];
#pragma unroll
    for (int a = 0; a < 2; ++a)
#pragma unroll
        for (int b = 0; b < 2; ++b)
#pragma unroll
            for (int m = 0; m < 4; ++m)
#pragma unroll
                for (int n = 0; n < 2; ++n) acc[a][b][m][n] = (f32x4){0.f, 0.f, 0.f, 0.f};
    bf16x8 At[4][2], B0[2][2], B1[2][2];
    const char* cA = (const char*)g.A + (size_t)cur.pm * tstep; const char* cB = (const char*)g.Bt + (size_t)cur.pn * tstep;
    S.a_ready(cur);
    if constexpr (SP2) {
        PG8_STAGE(PG8_SB(0, 0), cB, voffB); PG8_STAGE(PG8_SB(0, 1), cB + hstep, voffB); PG8_STAGE(PG8_SA(0, 0), cA, voffA); PG8_STAGE(PG8_SA(0, 1), cA + hstep, voffA);
        if (wr == 1) PG8_BAR;
        PG8_WAIT_V(2); PG8_BAR;
        PG8_STAGE(PG8_SB(1, 0), cB + kstep, voffB); PG8_STAGE(PG8_SA(1, 0), cA + kstep, voffA); PG8_STAGE(PG8_SB(1, 1), cB + hstep + kstep, voffB);
        PG8_WAIT_V(6); PG8_BAR;
    } else {
        PG8_STAGE(PG8_SB(0, 0), cB, voffB); PG8_STAGE(PG8_SA(0, 0), cA, voffA); PG8_STAGE(PG8_SB(0, 1), cB + hstep, voffB); PG8_STAGE(PG8_SA(0, 1), cA + hstep, voffA);
        if (wr == 1) PG8_BAR;
        PG8_WAIT_V(4); PG8_BAR;
        PG8_STAGE(PG8_SB(1, 0), cB + kstep, voffB); PG8_STAGE(PG8_SA(1, 0), cA + kstep, voffA); PG8_STAGE(PG8_SB(1, 1), cB + hstep + kstep, voffB);
        PG8_WAIT_V(6); PG8_BAR;
    }
    for (;;) {
        const bool has_next = S.next(ui + 1, nxt);
        const char* nA = has_next ? (const char*)g.A + (size_t)nxt.pm * tstep : cA; const char* nB = has_next ? (const char*)g.Bt + (size_t)nxt.pn * tstep : cB;
        for (int t = 0; t < nt; t += 2) {
            const bool last = (t == nt - 2);
            const char* a1 = cA + (size_t)(t + 1) * kstep;
            const char* a2 = last ? nA : cA + (size_t)(t + 2) * kstep; const char* b2 = last ? nB : cB + (size_t)(t + 2) * kstep;
            const char* a3 = a2 + kstep; const char* b3 = b2 + kstep;
            if (last && has_next) S.a_ready(nxt);
            if constexpr (SP2) {
            PG8_LDB(B0, 0, 0); PG8_LDB(B1, 0, 1); PG8_SCHED; PG8_LDA(At, 0, 0); PG8_STAGE(PG8_SA(1, 1), a1 + hstep, voffA);
            PG8_WAIT_V(8); PG8_WAIT_L(0); PG8_BAR; PG8_MMA(0, 0, At, B0); PG8_MMA(0, 1, At, B1); PG8_BAR; PG8_SCHED;
            PG8_LDA(At, 0, 1); PG8_STAGE(PG8_SB(0, 0), b2, voffB); PG8_STAGE(PG8_SB(0, 1), b2 + hstep, voffB); PG8_STAGE(PG8_SA(0, 0), a2, voffA);
            PG8_WAIT_V(8); PG8_WAIT_L(0); PG8_BAR; PG8_MMA(1, 0, At, B0); PG8_MMA(1, 1, At, B1); PG8_BAR; PG8_SCHED;
            PG8_LDB(B0, 1, 0); PG8_LDB(B1, 1, 1); PG8_SCHED; PG8_LDA(At, 1, 0); PG8_STAGE(PG8_SA(0, 1), a2 + hstep, voffA);
            PG8_WAIT_V(8); PG8_WAIT_L(0); PG8_BAR; PG8_MMA(0, 0, At, B0); PG8_MMA(0, 1, At, B1); PG8_BAR; PG8_SCHED;
            PG8_LDA(At, 1, 1); PG8_STAGE(PG8_SB(1, 0), b3, voffB); PG8_STAGE(PG8_SB(1, 1), b3 + hstep, voffB); PG8_STAGE(PG8_SA(1, 0), a3, voffA);
            PG8_WAIT_V(8); PG8_WAIT_L(0); PG8_BAR; PG8_MMA(1, 0, At, B0); PG8_MMA(1, 1, At, B1); PG8_BAR; PG8_SCHED;
            } else {
            PG8_LDB(B0, 0, 0); PG8_SCHED; PG8_LDA(At, 0, 0); PG8_STAGE(PG8_SA(1, 1), a1 + hstep, voffA);
            PG8_WAIT_L(8); PG8_BAR; PG8_WAIT_L(0); PG8_MMA(0, 0, At, B0); PG8_BAR; PG8_SCHED;
            PG8_LDB(B1, 0, 1); PG8_STAGE(PG8_SB(0, 0), b2, voffB);
            PG8_BAR; PG8_WAIT_L(0); PG8_MMA(0, 1, At, B1); PG8_BAR;
            PG8_LDA(At, 0, 1); PG8_STAGE(PG8_SA(0, 0), a2, voffA);
            PG8_BAR; PG8_WAIT_L(0); PG8_MMA(1, 0, At, B0); PG8_BAR; PG8_SCHED;
            PG8_STAGE(PG8_SB(0, 1), b2 + hstep, voffB);
            PG8_WAIT_V(6); PG8_BAR; PG8_MMA(1, 1, At, B1); PG8_BAR;
            PG8_LDB(B0, 1, 0); PG8_SCHED; PG8_LDA(At, 1, 0); PG8_STAGE(PG8_SA(0, 1), a2 + hstep, voffA);
            PG8_WAIT_L(8); PG8_BAR; PG8_WAIT_L(0); PG8_MMA(0, 0, At, B0); PG8_BAR; PG8_SCHED;
            PG8_LDB(B1, 1, 1); PG8_STAGE(PG8_SB(1, 0), b3, voffB);
            PG8_BAR; PG8_WAIT_L(0); PG8_MMA(0, 1, At, B1); PG8_BAR;
            PG8_LDA(At, 1, 1); PG8_STAGE(PG8_SA(1, 0), a3, voffA);
            PG8_BAR; PG8_WAIT_L(0); PG8_MMA(1, 0, At, B0); PG8_BAR; PG8_SCHED;
            PG8_STAGE(PG8_SB(1, 1), b3 + hstep, voffB);
            PG8_WAIT_V(6); PG8_BAR; PG8_MMA(1, 1, At, B1); PG8_BAR;
            }
        }
        if constexpr (ALIGN_EPI) { if (wr == 0) PG8_BAR; }
        if constexpr (!Epi::AFTER_DRAIN) { E(acc, cur, wr, wc, fr, fq); S.done(cur); }
        if (!has_next) break;
#pragma unroll
        for (int a = 0; a < 2; ++a)
#pragma unroll
            for (int b = 0; b < 2; ++b)
#pragma unroll
                for (int m = 0; m < 4; ++m)
#pragma unroll
                    for (int n = 0; n < 2; ++n) acc[a][b][m][n] = (f32x4){0.f, 0.f, 0.f, 0.f};
        cur = nxt; cA = nA; cB = nB; ++ui;
        if constexpr (ALIGN_EPI) { if (wr == 1) PG8_BAR; }
    }
    PG8_WAIT_V(0);
    if constexpr (!ALIGN_EPI) { if (wr == 0) PG8_BAR; }
    PG8_BAR;
    if constexpr (Epi::AFTER_DRAIN) { E.fused(acc, cur, wr, wc, fr, fq, lds, wid, lane); S.done(cur); }
#undef PG8_SA
#undef PG8_SB
#undef PG8_STAGE
#undef PG8_LDA
#undef PG8_LDB
#undef PG8_MMA
#undef PG8_WAIT_V
#undef PG8_WAIT_L
#undef PG8_BAR
#undef PG8_SCHED
}
}

namespace att {
using bf16 = __hip_bfloat16;
constexpr int   D = 128, NW = 8, QBLK = 32, KVBLK = 64;
constexpr float SCALE = 0.088388347648318440f;
constexpr float THR = 8.f;
constexpr int SDEPTH = 2;
constexpr int LDQ = 2048, LDK = 2048, LDO = 4096;
constexpr size_t SHM_V = KVBLK * D * 2, SHM_K = KVBLK * D * 2, SHM_ATTN = 2 * SHM_V + 2 * SHM_K + NW * 64 * 4;
using bf16x8 = __attribute__((ext_vector_type(8))) short;
using s16x4  = __attribute__((ext_vector_type(4))) short;
using f32x16 = __attribute__((ext_vector_type(16))) float;
using f32x8  = __attribute__((ext_vector_type(8))) float;
using u32x4  = __attribute__((ext_vector_type(4))) unsigned;
#define KSWZ(row, colB) ((row) * 256 + ((colB) ^ (((row) & 7) << 4)))
#define SBAR() __builtin_amdgcn_sched_barrier(0)
__device__ __forceinline__ int crow(int r, int hi) { return (r & 3) + 8 * (r >> 2) + 4 * hi; }
__device__ __forceinline__ unsigned cvtpk(float lo, float hi) {
  unsigned r; asm volatile("v_cvt_pk_bf16_f32 %0, %1, %2" : "=v"(r) : "v"(lo), "v"(hi)); return r;
}
template <typename TIn> struct Stage;
template <> struct Stage<bf16>  { using T = bf16x8;
  __device__ static __forceinline__ T ld8(const bf16* p) { return *reinterpret_cast<const bf16x8*>(p); }
  __device__ static __forceinline__ bf16x8 tobf(T x) { return x; } };
template <> struct Stage<float> { using T = f32x8;
  __device__ static __forceinline__ T ld8(const float* p) { return *reinterpret_cast<const f32x8*>(p); }
  __device__ static __forceinline__ bf16x8 tobf(T x) {
    u32x4 w = {cvtpk(x[0], x[1]), cvtpk(x[2], x[3]), cvtpk(x[4], x[5]), cvtpk(x[6], x[7])}; return *reinterpret_cast<bf16x8*>(&w); } };

__device__ __forceinline__ void partialSM(f32x16& p0, f32x16& p1, float& m_reg, float& mn, float& alpha) {
  constexpr float C = SCALE * 1.4426950408889634f;
  float pmax = p0[0]; for (int r = 1; r < 16; ++r) pmax = fmaxf(pmax, p0[r]); for (int r = 0; r < 16; ++r) pmax = fmaxf(pmax, p1[r]);
  { auto rr = __builtin_amdgcn_permlane32_swap(__float_as_uint(pmax), __float_as_uint(pmax), false, false);
    pmax = fmaxf(__uint_as_float(rr[0]), __uint_as_float(rr[1])); }
  if (__builtin_expect(__all(pmax - m_reg <= THR / SCALE), 1)) { mn = m_reg; alpha = 1.f; }
  else { mn = fmaxf(m_reg, pmax); alpha = __builtin_amdgcn_exp2f((m_reg - mn) * C); m_reg = mn; }
  float mnC = -mn * C;
  for (int r = 0; r < 16; ++r) p0[r] = fmaf(p0[r], C, mnC); for (int r = 0; r < 16; ++r) p1[r] = fmaf(p1[r], C, mnC);
  for (int r = 0; r < 16; ++r) p0[r] = __builtin_amdgcn_exp2f(p0[r]);
}
__device__ __forceinline__ void finishSM(f32x16& p0, f32x16& p1, float alpha, float& l_reg, bf16x8& pa0, bf16x8& pa1, bf16x8& pa2, bf16x8& pa3) {
  for (int r = 0; r < 16; ++r) p1[r] = __builtin_amdgcn_exp2f(p1[r]);
  float ps = 0; for (int r = 0; r < 16; ++r) ps += p0[r]; for (int r = 0; r < 16; ++r) ps += p1[r];
  { auto rr = __builtin_amdgcn_permlane32_swap(__float_as_uint(ps), __float_as_uint(ps), false, false);
    ps = __uint_as_float(rr[0]) + __uint_as_float(rr[1]); }
  l_reg = l_reg * alpha + ps;
#define PK4(P, BASE, OUT) do { unsigned a0 = cvtpk(P[BASE + 0], P[BASE + 1]), a1 = cvtpk(P[BASE + 2], P[BASE + 3]);   \
    unsigned b0 = cvtpk(P[BASE + 4], P[BASE + 5]), b1 = cvtpk(P[BASE + 6], P[BASE + 7]);                              \
    auto r0 = __builtin_amdgcn_permlane32_swap(a0, b0, false, false); auto r1 = __builtin_amdgcn_permlane32_swap(a1, b1, false, false); \
    u32x4 w = {r0[0], r1[0], r0[1], r1[1]}; OUT = *reinterpret_cast<bf16x8*>(&w); } while (0)
  PK4(p0, 0, pa0); PK4(p0, 8, pa1); PK4(p1, 0, pa2); PK4(p1, 8, pa3);
#undef PK4
}
__device__ __forceinline__ void qkt(f32x16& p0, f32x16& p1, const bf16* Ks, const bf16x8* qr, int r32, int hi) {
  p0 = f32x16{}; p1 = f32x16{};
  for (int d0 = 0; d0 < 8; ++d0) { int cb = (d0 * 16 + hi * 8) * 2;
    bf16x8 b0 = *reinterpret_cast<const bf16x8*>((const char*)Ks + KSWZ(r32, cb));
    bf16x8 b1 = *reinterpret_cast<const bf16x8*>((const char*)Ks + KSWZ(32 + r32, cb));
    p0 = __builtin_amdgcn_mfma_f32_32x32x16_bf16(b0, qr[d0], p0, 0, 0, 0);
    p1 = __builtin_amdgcn_mfma_f32_32x32x16_bf16(b1, qr[d0], p1, 0, 0, 0); }
}
__device__ __forceinline__ int v_st(int k, int c) { const int kk = (k & ~0xC) | ((k & 4) << 1) | ((k & 8) >> 1); return ((kk >> 3) * 4 + (c >> 5)) * 512 + ((kk & 7) * 32 + (c & 31)) * 2; }
__device__ __forceinline__ int v_rd_base(int lane) { return ((lane & 3) << 3) | (((lane >> 2) & 3) << 6) | (((lane >> 4) & 1) << 5) | (((lane >> 5) & 1) << 8); }
constexpr int v_rd_off(int d0, int ks, int half) { return d0 * 512 + ks * 4096 + half * 2048; }
template <int OFF> __device__ __forceinline__ s16x4 tr_read(int vb) {
  s16x4 r; asm volatile("ds_read_b64_tr_b16 %0, %1 offset:%2" : "=&v"(r) : "v"(vb), "i"(OFF) : "memory"); return r;
}
template <int D0> __device__ __forceinline__ void pv_one(f32x16& od, int vb, bf16x8 pa0, bf16x8 pa1, bf16x8 pa2, bf16x8 pa3) {
  const s16x4 l0 = tr_read<v_rd_off(D0, 0, 0)>(vb), h0 = tr_read<v_rd_off(D0, 0, 1)>(vb), l1 = tr_read<v_rd_off(D0, 1, 0)>(vb), h1 = tr_read<v_rd_off(D0, 1, 1)>(vb);
  const s16x4 l2 = tr_read<v_rd_off(D0, 2, 0)>(vb), h2 = tr_read<v_rd_off(D0, 2, 1)>(vb), l3 = tr_read<v_rd_off(D0, 3, 0)>(vb), h3 = tr_read<v_rd_off(D0, 3, 1)>(vb);
  asm volatile("s_waitcnt lgkmcnt(0)" ::: "memory"); SBAR();
#define PK(L, H) (bf16x8){L[0], L[1], L[2], L[3], H[0], H[1], H[2], H[3]}
  od = __builtin_amdgcn_mfma_f32_32x32x16_bf16(pa0, PK(l0, h0), od, 0, 0, 0);
  od = __builtin_amdgcn_mfma_f32_32x32x16_bf16(pa1, PK(l1, h1), od, 0, 0, 0);
  od = __builtin_amdgcn_mfma_f32_32x32x16_bf16(pa2, PK(l2, h2), od, 0, 0, 0);
  od = __builtin_amdgcn_mfma_f32_32x32x16_bf16(pa3, PK(l3, h3), od, 0, 0, 0);
#undef PK
}
__device__ __forceinline__ void pv_d0(f32x16* o, int vb, bf16x8 pa0, bf16x8 pa1, bf16x8 pa2, bf16x8 pa3) {
  pv_one<0>(o[0], vb, pa0, pa1, pa2, pa3); pv_one<1>(o[1], vb, pa0, pa1, pa2, pa3); pv_one<2>(o[2], vb, pa0, pa1, pa2, pa3); pv_one<3>(o[3], vb, pa0, pa1, pa2, pa3);
}


__device__ __forceinline__ void att_lds_barrier() { asm volatile("s_waitcnt lgkmcnt(0)\n\ts_barrier" ::: "memory"); }
template <typename TQ>
__device__ __forceinline__ void attn_dense_body(const TQ* __restrict__ Qb, const bf16* __restrict__ Kh, const bf16* __restrict__ Vh,
                                                bf16* __restrict__ Ob, int seq, char* lds) {
  using St = Stage<bf16>; using SQ = Stage<TQ>;
  int tid_ = threadIdx.x; asm volatile("" : "+v"(tid_));
  const int tid = tid_, wid = tid >> 6, lane = tid & 63, r32 = lane & 31, hi = lane >> 5;
  bf16* V_lds = (bf16*)lds; bf16* K_lds = (bf16*)(lds + 2 * SHM_V);
  float* ws = (float*)(lds + 2 * SHM_V + 2 * SHM_K) + wid * 64; float* li_l = ws; float* al_l = ws + 32;
  float m_reg = -1e30f, l_reg = 0; f32x16 o[4] = {}; bf16x8 qr[8];
  const TQ* Qw = Qb + (long)(wid * QBLK + r32) * LDQ + hi * 8;
#pragma unroll
  for (int d0 = 0; d0 < 8; ++d0) qr[d0] = SQ::tobf(SQ::ld8(Qw + d0 * 16));
  const int sr = tid >> 4, sc = (tid & 15) * 8, vst0 = v_st(sr, sc), vst1 = v_st(32 + sr, sc);
  const int vb0 = (int)(uintptr_t)V_lds + v_rd_base(lane);
  struct { typename St::T vs0, vs1, ks0, ks1; } sr_[SDEPTH];
#define SLOAD(i, k0) do { sr_[i].vs0 = St::ld8(&Vh[(long)((k0) + sr) * LDK + sc]); sr_[i].vs1 = St::ld8(&Vh[(long)((k0) + 32 + sr) * LDK + sc]); \
    sr_[i].ks0 = St::ld8(&Kh[(long)((k0) + sr) * LDK + sc]); sr_[i].ks1 = St::ld8(&Kh[(long)((k0) + 32 + sr) * LDK + sc]); } while (0)
#define SWRITE(b, i) do { *(bf16x8*)((char*)V_lds + (b) * SHM_V + vst0) = St::tobf(sr_[i].vs0);          \
    *(bf16x8*)((char*)V_lds + (b) * SHM_V + vst1) = St::tobf(sr_[i].vs1); int kc = sc * 2;               \
    *(bf16x8*)((char*)K_lds + (b) * SHM_K + KSWZ(sr, kc)) = St::tobf(sr_[i].ks0);                       \
    *(bf16x8*)((char*)K_lds + (b) * SHM_K + KSWZ(32 + sr, kc)) = St::tobf(sr_[i].ks1); } while (0)
#define SWAIT() do { if constexpr (SDEPTH == 2) asm volatile("s_waitcnt vmcnt(4)" ::: "memory"); else asm volatile("s_waitcnt vmcnt(0)" ::: "memory"); } while (0)
#define RESC(a) do { if (__any((a) < 1.f)) { if (hi == 0) al_l[r32] = (a); asm volatile("s_waitcnt lgkmcnt(0)" ::: "memory"); \
    for (int d = 0; d < 4; ++d) for (int r = 0; r < 16; ++r) o[d][r] *= al_l[crow(r, hi)]; } } while (0)
  f32x16 pA0, pA1, pB0, pB1; float mnA, mnB, alA, alB; bf16x8 pa0, pa1, pa2, pa3; const int NT = seq / KVBLK;
  constexpr int SE = 0, SO = SDEPTH - 1;
  SLOAD(SE, 0); asm volatile("s_waitcnt vmcnt(0)" ::: "memory"); SWRITE(0, SE); att_lds_barrier();
  qkt(pA0, pA1, K_lds, qr, r32, hi); partialSM(pA0, pA1, m_reg, mnA, alA);
  SLOAD(SO, KVBLK); if constexpr (SDEPTH == 2) { if (2 < NT) SLOAD(SE, 2 * KVBLK); }
  SWAIT(); SWRITE(1, SO); att_lds_barrier();
  for (int j = 1; j + 1 < NT; j += 2) {
    SBAR(); qkt(pB0, pB1, (bf16*)((char*)K_lds + SHM_K), qr, r32, hi);
    finishSM(pA0, pA1, alA, l_reg, pa0, pa1, pa2, pa3); SBAR();
    SLOAD(SO, (j + SDEPTH) * KVBLK); SBAR();
    pv_d0(o, vb0, pa0, pa1, pa2, pa3); partialSM(pB0, pB1, m_reg, mnB, alB);
    att_lds_barrier(); SWAIT(); SWRITE(0, SE);
    RESC(alB); att_lds_barrier();
    SBAR(); qkt(pA0, pA1, K_lds, qr, r32, hi);
    finishSM(pB0, pB1, alB, l_reg, pa0, pa1, pa2, pa3); SBAR();
    if (SDEPTH == 1 || j + 3 < NT) SLOAD(SE, (j + 1 + SDEPTH) * KVBLK); SBAR();
    pv_d0(o, vb0 + (int)SHM_V, pa0, pa1, pa2, pa3); partialSM(pA0, pA1, m_reg, mnA, alA);
    att_lds_barrier(); SWAIT(); SWRITE(1, SO);
    RESC(alA); att_lds_barrier();
  }
  SBAR(); qkt(pB0, pB1, (bf16*)((char*)K_lds + SHM_K), qr, r32, hi);
  finishSM(pA0, pA1, alA, l_reg, pa0, pa1, pa2, pa3); SBAR();
  pv_d0(o, vb0, pa0, pa1, pa2, pa3); partialSM(pB0, pB1, m_reg, mnB, alB);
  att_lds_barrier(); RESC(alB);
  finishSM(pB0, pB1, alB, l_reg, pa0, pa1, pa2, pa3); SBAR();
  pv_d0(o, vb0 + (int)SHM_V, pa0, pa1, pa2, pa3);
  if (hi == 0) li_l[r32] = l_reg; asm volatile("s_waitcnt lgkmcnt(0)" ::: "memory");
  float rli[16];
#pragma unroll
  for (int r = 0; r < 16; ++r) rli[r] = __builtin_amdgcn_rcpf(li_l[crow(r, hi)]);
  bf16* Ow = Ob + (long)(wid * QBLK) * LDO;
#pragma unroll
  for (int r = 0; r < 16; ++r) { int orow = crow(r, hi);
    for (int d0 = 0; d0 < 4; ++d0) Ow[(long)orow * LDO + d0 * 32 + r32] = __float2bfloat16(o[d0][r] * rli[r]); }
#undef SLOAD
#undef SWRITE
#undef SWAIT
#undef RESC
}
#undef KSWZ
#undef SBAR
}

#define LAS __attribute__((address_space(3)))
typedef unsigned short bf16_t;
typedef float f32x4 __attribute__((ext_vector_type(4)));
typedef unsigned u32x4 __attribute__((ext_vector_type(4)));
typedef unsigned u32x2 __attribute__((ext_vector_type(2)));
typedef short bf16x8 __attribute__((ext_vector_type(8)));
typedef short s16x4v __attribute__((ext_vector_type(4)));

constexpr int DM = 2048, NPR = 4096, MTOT = 36864, DFF = 5632, NUP = 11264, NMOD = 12288;
constexpr float EPS = 1e-6f;
constexpr size_t MiB = (size_t)1 << 20;
constexpr size_t WS_MOD = 0, WS_LB = 1 * MiB, WS_ROPE = 1 * MiB + 65536, WS_BAR = 1 * MiB + 131072, BAR_BYTES = 16384;
constexpr size_t WS_WUP = 2 * MiB, WS_WDOWN = 46 * MiB, WS_WOUT = 68 * MiB, WS_WIN = 76 * MiB;
constexpr size_t WS_H = 116 * MiB, WS_B0 = 260 * MiB, SZ = 144 * MiB;
constexpr size_t WS_END = 1012 * MiB;
constexpr size_t OUT_STATE = (size_t)MTOT * DM, OUT_NK = OUT_STATE + 8388608, OUT_NV = OUT_NK + 8388608;
constexpr int LDS_BYTES = 147456;

__device__ __forceinline__ float fsigmoid(float z) { return __builtin_amdgcn_rcpf(1.f + __expf(-z)); }
__device__ __forceinline__ unsigned pkbf(float lo, float hi) { return pg8::cvt_pk_bf16(lo, hi); }
__device__ __forceinline__ float bflo(unsigned w) { return __uint_as_float(w << 16); }
__device__ __forceinline__ float bfhi(unsigned w) { return __uint_as_float(w & 0xffff0000u); }
typedef _Float16 h16x2 __attribute__((ext_vector_type(2)));
__device__ __forceinline__ unsigned pk_f16(float a, float b) { h16x2 v = {(_Float16)a, (_Float16)b}; return __builtin_bit_cast(unsigned, v); }
__device__ __forceinline__ float f16lo(unsigned w) { h16x2 v = __builtin_bit_cast(h16x2, w); return (float)v.x; }
__device__ __forceinline__ float f16hi(unsigned w) { h16x2 v = __builtin_bit_cast(h16x2, w); return (float)v.y; }
__device__ __forceinline__ float shx(float v, int o, int lane) { return __builtin_bit_cast(float, __builtin_amdgcn_ds_bpermute((lane ^ o) << 2, __builtin_bit_cast(int, v))); }
__device__ __forceinline__ float wave_sum(float v, int lane) {
#pragma unroll
    for (int o = 1; o < 64; o <<= 1) v += shx(v, o, lane);
    return v;
}
__device__ __forceinline__ void lds_barrier() { asm volatile("s_waitcnt lgkmcnt(0)\n\ts_barrier" ::: "memory"); }
template <int CTRL> __device__ __forceinline__ float dppo(float old, float v) { return __builtin_bit_cast(float, __builtin_amdgcn_update_dpp(__builtin_bit_cast(int, old), __builtin_bit_cast(int, v), CTRL, 0xf, 0xf, false)); }
template <int CTRL> __device__ __forceinline__ float dppf(float v) { return __builtin_bit_cast(float, __builtin_amdgcn_update_dpp(0, __builtin_bit_cast(int, v), CTRL, 0xf, 0xf, true)); }
__device__ __forceinline__ void unpack8(const u32x4 w, float* f) {
    f[0] = bflo(w.x); f[1] = bfhi(w.x); f[2] = bflo(w.y); f[3] = bfhi(w.y); f[4] = bflo(w.z); f[5] = bfhi(w.z); f[6] = bflo(w.w); f[7] = bfhi(w.w);
}
__device__ __forceinline__ u32x4 pack8(const float* f) { u32x4 w; w.x = pkbf(f[0], f[1]); w.y = pkbf(f[2], f[3]); w.z = pkbf(f[4], f[5]); w.w = pkbf(f[6], f[7]); return w; }

struct EpiHgrnIn {
    static constexpr bool PERM = true, AFTER_DRAIN = false;
    bf16_t* base; const float* lb;
    __device__ __forceinline__ void operator()(const pg8::f32x4 (&acc)[2][2][4][2], const pg8::Unit& u, int wr, int wc, int fr, int fq) const {
        int opq = 0; asm volatile("" : "+v"(opq));
        const int type = u.pn >> 3;
        const int cb = (u.pn & 7) * 256 + wc * 32 + 8 * fq + opq;
        const int row0 = u.pm * 256 + wr * 64 + fr;
        if (type == 1 || type == 2) {
            bf16_t* dst = base + (size_t)type * (SZ / 2); const float* lbp = lb + (type - 1) * DM;
#pragma unroll
            for (int bj = 0; bj < 2; ++bj) { const int col = cb + bj * 128;
                const f32x4 l0 = *(const f32x4*)(lbp + col), l1 = *(const f32x4*)(lbp + col + 4);
#pragma unroll
                for (int ai = 0; ai < 2; ++ai)
#pragma unroll
                    for (int m = 0; m < 4; ++m) { const size_t row = row0 + ai * 128 + m * 16;
                        const f32x4 z0 = acc[ai][bj][m][0], z1 = acc[ai][bj][m][1]; float lf[8];
#pragma unroll
                        for (int e = 0; e < 4; ++e) { lf[e] = __log2f(l0[e] + (1.f - l0[e]) * fsigmoid(z0[e])); lf[4 + e] = __log2f(l1[e] + (1.f - l1[e]) * fsigmoid(z1[e])); }
                        u32x4 w; w.x = pk_f16(lf[0], lf[1]); w.y = pk_f16(lf[2], lf[3]); w.z = pk_f16(lf[4], lf[5]); w.w = pk_f16(lf[6], lf[7]);
                        *(u32x4*)(dst + row * DM + col) = w; } }
        } else {
            bf16_t* dst = base + (size_t)type * (SZ / 2);
#pragma unroll
            for (int bj = 0; bj < 2; ++bj) { const int col = cb + bj * 128;
#pragma unroll
                for (int ai = 0; ai < 2; ++ai)
#pragma unroll
                    for (int m = 0; m < 4; ++m) { const size_t row = row0 + ai * 128 + m * 16;
                        const f32x4 v0 = acc[ai][bj][m][0], v1 = acc[ai][bj][m][1];
                        u32x4 w; w.x = pkbf(v0[0], v0[1]); w.y = pkbf(v0[2], v0[3]); w.z = pkbf(v1[0], v1[1]); w.w = pkbf(v1[2], v1[3]);
                        *(u32x4*)(dst + row * DM + col) = w; } }
        }
    }
};
struct EpiResid {
    static constexpr bool PERM = true, AFTER_DRAIN = false;
    const float* x0; const float* x1; float* out; const float* gate;
    __device__ __forceinline__ void operator()(const pg8::f32x4 (&acc)[2][2][4][2], const pg8::Unit& u, int wr, int wc, int fr, int fq) const {
        int opq = 0; asm volatile("" : "+v"(opq));
        const int cb = u.pn * 256 + wc * 32 + 8 * fq + opq;
        const int row0 = u.pm * 256 + wr * 64 + fr;
        const float* gp = gate + (size_t)((u.pm * 256) >> 12) * NMOD;
        const float* src0 = (u.pm < 16) ? x0 : x1 - (size_t)NPR * DM;
#pragma unroll
        for (int bj = 0; bj < 2; ++bj) { const int col = cb + bj * 128;
            const f32x4 g0 = *(const f32x4*)(gp + col), g1 = *(const f32x4*)(gp + col + 4);
#pragma unroll
            for (int ai = 0; ai < 2; ++ai) { f32x4 xa[4], xb[4];
#pragma unroll
                for (int m = 0; m < 4; ++m) { const size_t off = (size_t)(row0 + ai * 128 + m * 16) * DM + col; xa[m] = *(const f32x4*)(src0 + off); xb[m] = *(const f32x4*)(src0 + off + 4); }
#pragma unroll
                for (int m = 0; m < 4; ++m) { const size_t off = (size_t)(row0 + ai * 128 + m * 16) * DM + col;
                    *(f32x4*)(out + off) = xa[m] + g0 * acc[ai][bj][m][0]; *(f32x4*)(out + off + 4) = xb[m] + g1 * acc[ai][bj][m][1]; }
                asm volatile("" ::: "memory"); } }
    }
};
struct EpiFfnUp {
    static constexpr bool PERM = true, AFTER_DRAIN = false;
    bf16_t* A; bf16_t* halo; const float* cw; const float* cbias;
    __device__ __forceinline__ void operator()(const pg8::f32x4 (&acc)[2][2][4][2], const pg8::Unit& u, int wr, int wc, int fr, int fq) const {
        int opq = 0; asm volatile("" : "+v"(opq));
        const int c0 = u.pn * 128 + wc * 32 + 8 * fq + opq;
        const int rowg = u.pm * 256 + wr * 64;
#pragma unroll
        for (int n = 0; n < 2; ++n) { const int cg = c0 + 4 * n, cv = DFF + cg;
            const f32x4 g0 = *(const f32x4*)(cw + cg), g1 = *(const f32x4*)(cw + NUP + cg), g2 = *(const f32x4*)(cw + 2 * NUP + cg), gb = *(const f32x4*)(cbias + cg);
            const f32x4 v0 = *(const f32x4*)(cw + cv), v1 = *(const f32x4*)(cw + NUP + cv), v2 = *(const f32x4*)(cw + 2 * NUP + cv), vb = *(const f32x4*)(cbias + cv);
#pragma unroll
            for (int ai = 0; ai < 2; ++ai)
#pragma unroll
                for (int m = 0; m < 4; ++m) {
                    const f32x4 ug = acc[ai][0][m][n], uv = acc[ai][1][m][n]; f32x4 pg, ng, pv, nv;
#pragma unroll
                    for (int e = 0; e < 4; ++e) {
                        const float tpg = m > 0 ? dppf<0x10F>(acc[ai][0][m > 0 ? m - 1 : 0][n][e]) : 0.f, tpv = m > 0 ? dppf<0x10F>(acc[ai][1][m > 0 ? m - 1 : 0][n][e]) : 0.f;
                        const float tng = m < 3 ? dppf<0x11F>(acc[ai][0][m < 3 ? m + 1 : 3][n][e]) : 0.f, tnv = m < 3 ? dppf<0x11F>(acc[ai][1][m < 3 ? m + 1 : 3][n][e]) : 0.f;
                        pg[e] = dppo<0x111>(tpg, ug[e]); ng[e] = dppo<0x101>(tng, ug[e]); pv[e] = dppo<0x111>(tpv, uv[e]); nv[e] = dppo<0x101>(tnv, uv[e]); }
                    const f32x4 cgv = g0 * pg + g1 * ug + g2 * ng + gb, cvv = v0 * pv + v1 * uv + v2 * nv + vb; f32x4 o;
#pragma unroll
                    for (int e = 0; e < 4; ++e) o[e] = cgv[e] * fsigmoid(cgv[e]) * cvv[e];
                    const int r = 16 * m + fr;
                    if (r != 0 && r != 63) { u32x2 w; w.x = pkbf(o[0], o[1]); w.y = pkbf(o[2], o[3]); *(u32x2*)(A + (size_t)(rowg + ai * 128 + r) * DFF + cg) = w; }
                    if (r <= 1 || r >= 62) { const int slot = r <= 1 ? r : r - 60; bf16_t* hp = halo + (size_t)(((rowg + ai * 128) >> 6) * 4 + slot) * NUP;
                        u32x2 wg, wv; wg.x = pkbf(ug[0], ug[1]); wg.y = pkbf(ug[2], ug[3]); wv.x = pkbf(uv[0], uv[1]); wv.y = pkbf(uv[2], uv[3]);
                        *(u32x2*)(hp + cg) = wg; *(u32x2*)(hp + cv) = wv; }
                } }
    }
};
struct EpiAttnIn {
    static constexpr bool PERM = true, AFTER_DRAIN = false;
    bf16_t *Q, *KA, *VA, *KP, *VP; float* nk; float* nv; const float* tab;
    __device__ __forceinline__ void operator()(const pg8::f32x4 (&acc)[2][2][4][2], const pg8::Unit& u, int wr, int wc, int fr, int fq) const {
        int opq = 0; asm volatile("" : "+v"(opq));
        const int type = u.pn >> 3;
        const int cb = (u.pn & 7) * 256 + wc * 32 + 8 * fq + opq;
        const int rl = wr * 64 + fr;
        const bool prompt = u.pm < 16;
        bf16_t* dst; float* fdst = nullptr; size_t drow0;
        if (type == 0) { dst = Q; drow0 = (size_t)u.pm * 256; }
        else if (prompt) { dst = type == 1 ? KP : VP; drow0 = (size_t)u.pm * 256; fdst = type == 1 ? nk : nv; }
        else { const int sb = (u.pm - 16) >> 4, t0 = ((u.pm - 16) & 15) * 256; dst = type == 1 ? KA : VA; drow0 = (size_t)sb * 4608 + t0; }
        if (type == 2) {
#pragma unroll
            for (int bj = 0; bj < 2; ++bj) { const int col = cb + bj * 128;
#pragma unroll
                for (int ai = 0; ai < 2; ++ai)
#pragma unroll
                    for (int m = 0; m < 4; ++m) { const size_t off = (drow0 + rl + ai * 128 + m * 16) * DM + col;
                        const f32x4 v0 = acc[ai][bj][m][0], v1 = acc[ai][bj][m][1];
                        u32x4 w; w.x = pkbf(v0[0], v0[1]); w.y = pkbf(v0[2], v0[3]); w.z = pkbf(v1[0], v1[1]); w.w = pkbf(v1[2], v1[3]);
                        *(u32x4*)(dst + off) = w;
                        if (fdst) { *(f32x4*)(fdst + off) = v0; *(f32x4*)(fdst + off + 4) = v1; } } }
        } else {
            const int ax = wc >> 1, f0 = 16 * (wc & 1) + 4 * fq;
            const int tb = prompt ? 0 : ((u.pm - 16) & 15) * 256 + wr * 64 + fr;
#pragma unroll
            for (int ai = 0; ai < 2; ++ai)
#pragma unroll
                for (int m = 0; m < 4; ++m) { const int t = tb + ai * 128 + m * 16, pos = ax ? (t & 63) : (t >> 6);
                    f32x4 c0 = {1.f, 0.f, 1.f, 0.f}, c1 = c0;
                    if (!prompt) { const float* tp = tab + (pos * 32 + f0) * 2; c0 = *(const f32x4*)tp; c1 = *(const f32x4*)(tp + 4); }
#pragma unroll
                    for (int bj = 0; bj < 2; ++bj) { const int col = cb + bj * 128; const size_t off = (drow0 + rl + ai * 128 + m * 16) * DM + col;
                        const f32x4 v0 = acc[ai][bj][m][0], v1 = acc[ai][bj][m][1]; f32x4 r0, r1;
                        r0[0] = v0[0] * c0[0] - v0[1] * c0[1]; r0[1] = v0[1] * c0[0] + v0[0] * c0[1]; r0[2] = v0[2] * c0[2] - v0[3] * c0[3]; r0[3] = v0[3] * c0[2] + v0[2] * c0[3];
                        r1[0] = v1[0] * c1[0] - v1[1] * c1[1]; r1[1] = v1[1] * c1[0] + v1[0] * c1[1]; r1[2] = v1[2] * c1[2] - v1[3] * c1[3]; r1[3] = v1[3] * c1[2] + v1[2] * c1[3];
                        u32x4 w; w.x = pkbf(r0[0], r0[1]); w.y = pkbf(r0[2], r0[3]); w.z = pkbf(r1[0], r1[1]); w.w = pkbf(r1[2], r1[3]);
                        *(u32x4*)(dst + off) = w;
                        if (fdst) { const size_t lo = (drow0 + rl + ai * 128 + m * 16) * DM + (u.pn & 7) * 256 + bj * 128 + ax * 64 + f0 + opq;
                            *(f32x4*)(fdst + lo) = (f32x4){v0[0], v0[2], v1[0], v1[2]}; *(f32x4*)(fdst + lo + 32) = (f32x4){v0[1], v0[3], v1[1], v1[3]}; } } }
        }
    }
};

__device__ __forceinline__ void transpose_item(const float* W, int K, int N, bf16_t* WT, int mode, LAS float* scr, int item, int lane) {
    const int nblk = N / 32, kb = item / nblk, nb = item % nblk, k0 = 64 * kb, n0 = 32 * nb;
    int d0 = n0, dstr = 1;
    if (mode == 1) d0 = n0 < DFF ? (n0 >> 7) * 256 + (n0 & 127) : ((n0 - DFF) >> 7) * 256 + 128 + ((n0 - DFF) & 127);
    if (mode == 2 && n0 < 2 * DM) { d0 = (n0 & ~127) + (n0 & 64) + ((n0 >> 5) & 1); dstr = 2; }
#pragma unroll 16
    for (int i = 0; i < 32; ++i) { const int kk = 2 * i + (lane >> 5); scr[kk * 33 + (lane & 31)] = W[(size_t)(k0 + kk) * N + n0 + (lane & 31)]; }
    asm volatile("s_waitcnt lgkmcnt(0)" ::: "memory");
    const int c = lane & 7;
#pragma unroll
    for (int j = 0; j < 4; ++j) { const int n = (lane >> 3) + 8 * j; const LAS float* s = scr + (8 * c) * 33 + n;
        u32x4 o; o.x = pkbf(s[0 * 33], s[1 * 33]); o.y = pkbf(s[2 * 33], s[3 * 33]); o.z = pkbf(s[4 * 33], s[5 * 33]); o.w = pkbf(s[6 * 33], s[7 * 33]);
        *(u32x4*)(WT + (size_t)(d0 + n * dstr) * K + k0 + 8 * c) = o; }
    asm volatile("s_waitcnt lgkmcnt(0)" ::: "memory");
}
__device__ __forceinline__ const float* KIN(int k);
__device__ __forceinline__ void transpose_layer(int l, unsigned char* ws, LAS unsigned char* lds, int tw, int ntw, int wave, int lane) {
    LAS float* scr = (LAS float*)(lds + wave * 16384);
    const float* Win = KIN(l == 0 ? 11 : 15); const int Nin = l == 0 ? 10240 : 6144;
    const float* Wout = KIN(l == 0 ? 14 : 18);
    const float* Wup = KIN(19) + (size_t)l * DM * NUP; const float* Wdn = KIN(22) + (size_t)l * DFF * DM;
    const int I_in = 32 * (Nin / 32), I_out = 32 * 64, I_up = 32 * (NUP / 32), I_dn = (DFF / 64) * 64;
    const int total = I_in + I_out + I_up + I_dn;
    for (int it = tw; it < total; it += ntw) { int r = it;
        if (r < I_up) { transpose_item(Wup, DM, NUP, (bf16_t*)(ws + WS_WUP), 1, scr, r, lane); continue; } r -= I_up;
        if (r < I_in) { transpose_item(Win, DM, Nin, (bf16_t*)(ws + WS_WIN), l == 1 ? 2 : 0, scr, r, lane); continue; } r -= I_in;
        if (r < I_dn) { transpose_item(Wdn, DFF, DM, (bf16_t*)(ws + WS_WDOWN), 0, scr, r, lane); continue; } r -= I_dn;
        transpose_item(Wout, DM, DM, (bf16_t*)(ws + WS_WOUT), 0, scr, r, lane); }
}
__device__ __forceinline__ void mod_task(int task, const float* cvec, const float* cctx, const float* wmod, const float* bmod, float* mod, LAS unsigned char* lds, int tid, int wave, int lane) {
    LAS float* sil = (LAS float*)lds;
    LAS float* red = (LAS float*)(lds + 12288);
    const int kq = task & 7, cl = task >> 3, l = cl / 48, cgp = cl % 48, kbase = kq * 256;
    for (int i = tid; i < 9 * 256; i += 512) { const int n = i >> 8, k = i & 255; const float c = n == 0 ? cctx[kbase + k] : cvec[(n - 1) * DM + kbase + k]; sil[k * 12 + n] = c / (1.f + expf(-c)); }
    __syncthreads();
    const float* W = wmod + (size_t)l * DM * NMOD + (size_t)kbase * NMOD + cgp * 256 + lane * 4;
    float acc[9][4];
#pragma unroll
    for (int n = 0; n < 9; ++n)
#pragma unroll
        for (int e = 0; e < 4; ++e) acc[n][e] = 0.f;
#pragma unroll 8
    for (int kk = 0; kk < 32; ++kk) { const int k = wave * 32 + kk;
        const f32x4 w = *(const f32x4*)(W + (size_t)k * NMOD);
        const f32x4 s0 = *(const LAS f32x4*)(sil + k * 12), s1 = *(const LAS f32x4*)(sil + k * 12 + 4); const float s8 = sil[k * 12 + 8];
#pragma unroll
        for (int e = 0; e < 4; ++e) { acc[0][e] += s0[0] * w[e]; acc[1][e] += s0[1] * w[e]; acc[2][e] += s0[2] * w[e]; acc[3][e] += s0[3] * w[e];
            acc[4][e] += s1[0] * w[e]; acc[5][e] += s1[1] * w[e]; acc[6][e] += s1[2] * w[e]; acc[7][e] += s1[3] * w[e]; acc[8][e] += s8 * w[e]; } }
#pragma unroll
    for (int s = 4; s >= 1; s >>= 1) {
        if (wave >= s && wave < 2 * s) {
#pragma unroll
            for (int n = 0; n < 9; ++n)
#pragma unroll
                for (int e = 0; e < 4; ++e) red[((wave - s) * 36 + n * 4 + e) * 64 + lane] = acc[n][e]; }
        __syncthreads();
        if (wave < s) {
#pragma unroll
            for (int n = 0; n < 9; ++n)
#pragma unroll
                for (int e = 0; e < 4; ++e) acc[n][e] += red[(wave * 36 + n * 4 + e) * 64 + lane]; }
        __syncthreads();
    }
    if (wave == 0) { const int col = cgp * 256 + lane * 4; f32x4 b = {0.f, 0.f, 0.f, 0.f}; if (kq == 0) b = *(const f32x4*)(bmod + (size_t)l * NMOD + col);
#pragma unroll
        for (int n = 0; n < 9; ++n) { float* dst = mod + ((size_t)l * 9 + n) * NMOD + col;
#pragma unroll
            for (int e = 0; e < 4; ++e) __builtin_amdgcn_global_atomic_fadd_f32((__attribute__((address_space(1))) float*)(dst + e), acc[n][e] + b[e]); } }
    __syncthreads();
}
__device__ __forceinline__ void norm_pass(const float* x0, const float* x1, const float* g, const float* modl, int shk, int sck, bf16_t* H, int gw, int ngw, int lane) {
    for (int rowa = gw; rowa < MTOT; rowa += 2 * ngw) { const int rowb = rowa + ngw < MTOT ? rowa + ngw : rowa;
        const float* xa = rowa < NPR ? x0 + (size_t)rowa * DM : x1 + (size_t)(rowa - NPR) * DM;
        const float* xb = rowb < NPR ? x0 + (size_t)rowb * DM : x1 + (size_t)(rowb - NPR) * DM;
        f32x4 va[8], vb[8]; float sa = 0.f, sb = 0.f;
#pragma unroll
        for (int j = 0; j < 8; ++j) { va[j] = *(const f32x4*)(xa + 4 * (lane + 64 * j)); vb[j] = *(const f32x4*)(xb + 4 * (lane + 64 * j)); }
#pragma unroll
        for (int j = 0; j < 8; ++j) { sa += va[j][0] * va[j][0] + va[j][1] * va[j][1] + va[j][2] * va[j][2] + va[j][3] * va[j][3]; sb += vb[j][0] * vb[j][0] + vb[j][1] * vb[j][1] + vb[j][2] * vb[j][2] + vb[j][3] * vb[j][3]; }
#pragma unroll
        for (int o = 1; o < 64; o <<= 1) { sa += shx(sa, o, lane); sb += shx(sb, o, lane); }
        const float ra = rsqrtf(sa * (1.f / DM) + EPS), rb = rsqrtf(sb * (1.f / DM) + EPS);
        const float* ma = modl + (size_t)(rowa >> 12) * NMOD; const float* mb = modl + (size_t)(rowb >> 12) * NMOD;
#pragma unroll
        for (int j = 0; j < 8; ++j) { const int c = 4 * (lane + 64 * j); const f32x4 gg = *(const f32x4*)(g + c);
            const f32x4 sca = *(const f32x4*)(ma + sck * DM + c), sha = *(const f32x4*)(ma + shk * DM + c), scb = *(const f32x4*)(mb + sck * DM + c), shb = *(const f32x4*)(mb + shk * DM + c);
            const f32x4 oa = (va[j] * ra * gg) * (sca + 1.f) + sha, ob = (vb[j] * rb * gg) * (scb + 1.f) + shb;
            u32x2 wa, wb; wa.x = pkbf(oa[0], oa[1]); wa.y = pkbf(oa[2], oa[3]); wb.x = pkbf(ob[0], ob[1]); wb.y = pkbf(ob[2], ob[3]);
            *(u32x2*)(H + (size_t)rowa * DM + c) = wa; *(u32x2*)(H + (size_t)rowb * DM + c) = wb; }
    }
}
__device__ __forceinline__ void final_norm(float* x, const float* g, int gw, int ngw, int lane, float* dst = nullptr) {
    for (int rowa = gw; rowa < MTOT; rowa += 2 * ngw) { const int rowb = rowa + ngw < MTOT ? rowa + ngw : rowa;
        float* xa = x + (size_t)rowa * DM; float* xb = x + (size_t)rowb * DM; float* da = dst ? dst + (size_t)rowa * DM : xa; float* db = dst ? dst + (size_t)rowb * DM : xb;
        f32x4 va[8], vb[8]; float sa = 0.f, sb = 0.f;
#pragma unroll
        for (int j = 0; j < 8; ++j) { va[j] = *(const f32x4*)(xa + 4 * (lane + 64 * j)); vb[j] = *(const f32x4*)(xb + 4 * (lane + 64 * j)); }
#pragma unroll
        for (int j = 0; j < 8; ++j) { sa += va[j][0] * va[j][0] + va[j][1] * va[j][1] + va[j][2] * va[j][2] + va[j][3] * va[j][3]; sb += vb[j][0] * vb[j][0] + vb[j][1] * vb[j][1] + vb[j][2] * vb[j][2] + vb[j][3] * vb[j][3]; }
#pragma unroll
        for (int o = 1; o < 64; o <<= 1) { sa += shx(sa, o, lane); sb += shx(sb, o, lane); }
        const float ra = rsqrtf(sa * (1.f / DM) + EPS), rb = rsqrtf(sb * (1.f / DM) + EPS);
#pragma unroll
        for (int j = 0; j < 8; ++j) { const int c = 4 * (lane + 64 * j); const f32x4 gg = *(const f32x4*)(g + c);
            *(f32x4*)(da + c) = va[j] * ra * gg; if (rowb != rowa) *(f32x4*)(db + c) = vb[j] * rb * gg; }
    }
}
__device__ __forceinline__ void hgrn_combine(const bf16_t* Of, const bf16_t* Ob, const bf16_t* G, const float* onorm, bf16_t* Y, int gw, int ngw, int lane) {
    const int ch = (lane & 15) * 8; const f32x4 w0 = *(const f32x4*)(onorm + ch), w1 = *(const f32x4*)(onorm + ch + 4);
    for (int row = gw; row < MTOT; row += ngw) { u32x4 ra[4], rb[4], rg[4];
#pragma unroll
        for (int j = 0; j < 4; ++j) { const size_t off = (size_t)row * DM + j * 512 + lane * 8; ra[j] = *(const u32x4*)(Of + off); rb[j] = *(const u32x4*)(Ob + off); rg[j] = *(const u32x4*)(G + off); }
#pragma unroll
        for (int j = 0; j < 4; ++j) { const size_t off = (size_t)row * DM + j * 512 + lane * 8;
            float a[8], b[8], gg[8]; unpack8(ra[j], a); unpack8(rb[j], b); unpack8(rg[j], gg);
            float ss = 0.f;
#pragma unroll
            for (int e = 0; e < 8; ++e) { a[e] += b[e]; ss += a[e] * a[e]; }
            ss += shx(ss, 1, lane); ss += shx(ss, 2, lane); ss += shx(ss, 4, lane); ss += shx(ss, 8, lane);
            const float rstd = rsqrtf(ss * (1.f / 128.f) + EPS);
#pragma unroll
            for (int e = 0; e < 8; ++e) a[e] = a[e] * rstd * (e < 4 ? w0[e] : w1[e - 4]) * (gg[e] * fsigmoid(gg[e]));
            *(u32x4*)(Y + off) = pack8(a); }
    }
}
__device__ __forceinline__ void attn_combine(const bf16_t* O4, const float* lamp, const float* subln, bf16_t* Y, int gw, int ngw, int lane) {
    const float lam_init = 0.8f - 0.6f * expf(-0.3f);
    const float p1 = wave_sum(lamp[lane] * lamp[128 + lane] + lamp[64 + lane] * lamp[192 + lane], lane);
    const float p2 = wave_sum(lamp[256 + lane] * lamp[384 + lane] + lamp[320 + lane] * lamp[448 + lane], lane);
    const float lam = expf(p1) - expf(p2) + lam_init;
    const int e0 = (lane & 31) * 8; const f32x4 w0 = *(const f32x4*)(subln + e0), w1 = *(const f32x4*)(subln + e0 + 4);
    for (int row = gw; row < MTOT; row += ngw) { u32x4 ra[4], rb[4];
#pragma unroll
        for (int j = 0; j < 4; ++j) { const int head = 2 * j + (lane >> 5); const size_t off = (size_t)row * 4096 + head * 512 + e0; ra[j] = *(const u32x4*)(O4 + off); rb[j] = *(const u32x4*)(O4 + off + 256); }
#pragma unroll
        for (int j = 0; j < 4; ++j) { const int head = 2 * j + (lane >> 5);
            float a[8], b[8]; unpack8(ra[j], a); unpack8(rb[j], b);
            float ss = 0.f;
#pragma unroll
            for (int e = 0; e < 8; ++e) { a[e] -= lam * b[e]; ss += a[e] * a[e]; }
            ss += shx(ss, 1, lane); ss += shx(ss, 2, lane); ss += shx(ss, 4, lane); ss += shx(ss, 8, lane); ss += shx(ss, 16, lane);
            const float rstd = rsqrtf(ss * (1.f / 256.f) + EPS) * (1.f - lam_init);
#pragma unroll
            for (int e = 0; e < 8; ++e) a[e] = a[e] * rstd * (e < 4 ? w0[e] : w1[e - 4]);
            *(u32x4*)(Y + (size_t)row * DM + head * 256 + e0) = pack8(a); }
    }
}
__device__ __forceinline__ void rope_pass(bf16_t* Q, bf16_t* KA, const float* tab, int gw, int ngw, int lane, long dsto = 0) {
    for (int task = gw; task < 65536; task += ngw) { const int arr = task >> 15, st = task & 32767, b = st >> 12, t = st & 4095;
        bf16_t* rowp = arr == 0 ? Q + (size_t)(NPR + st) * DM : KA + (size_t)(b * 4608 + t) * DM;
        u32x4 r1[2], r2[2];
#pragma unroll
        for (int i = 0; i < 2; ++i) { const int T = lane + 64 * i, head = T >> 3, ax = (T >> 2) & 1, f0 = (T & 3) * 8; const bf16_t* p1 = rowp + head * 128 + ax * 64 + f0; r1[i] = *(const u32x4*)p1; r2[i] = *(const u32x4*)(p1 + 32); }
#pragma unroll
        for (int i = 0; i < 2; ++i) { const int T = lane + 64 * i, head = T >> 3, ax = (T >> 2) & 1, f0 = (T & 3) * 8, pos = ax ? (t & 63) : (t >> 6);
            bf16_t* p1 = rowp + head * 128 + ax * 64 + f0; float x1[8], x2[8]; unpack8(r1[i], x1); unpack8(r2[i], x2);
            const float* tp = tab + (pos * 32 + f0) * 2; float o1[8], o2[8];
#pragma unroll
            for (int q = 0; q < 4; ++q) { const f32x4 cs = *(const f32x4*)(tp + 4 * q);
                o1[2 * q] = x1[2 * q] * cs[0] - x2[2 * q] * cs[1]; o2[2 * q] = x2[2 * q] * cs[0] + x1[2 * q] * cs[1];
                o1[2 * q + 1] = x1[2 * q + 1] * cs[2] - x2[2 * q + 1] * cs[3]; o2[2 * q + 1] = x2[2 * q + 1] * cs[2] + x1[2 * q + 1] * cs[3]; }
            *(u32x4*)(p1 + dsto) = pack8(o1); *(u32x4*)(p1 + 32 + dsto) = pack8(o2); }
    }
}
__device__ __forceinline__ void cache_convert(const float* ck, const float* cv, bf16_t* KA, bf16_t* VA, int gw, int ngw, int lane) {
    for (int task = gw; task < 4096 * 4; task += ngw) { const int r = task >> 2, part = task & 3, b = r >> 9, p = r & 511;
        const float* src = cv + (size_t)r * DM + part * 512 + lane * 8; bf16_t* dst = VA + (size_t)(b * 4608 + 4096 + p) * DM + part * 512 + lane * 8;
        const f32x4 a = *(const f32x4*)src, c = *(const f32x4*)(src + 4);
        u32x4 w; w.x = pkbf(a[0], a[1]); w.y = pkbf(a[2], a[3]); w.z = pkbf(c[0], c[1]); w.w = pkbf(c[2], c[3]); *(u32x4*)dst = w; }
    for (int r = gw; r < 4096; r += ngw) { const int b = r >> 9, p = r & 511;
        const float* srow = ck + (size_t)r * DM; bf16_t* drow = KA + (size_t)(b * 4608 + 4096 + p) * DM;
#pragma unroll
        for (int i = 0; i < 2; ++i) { const int T = lane + 64 * i, head = T >> 3, ax = (T >> 2) & 1, f0 = (T & 3) * 8;
            const float* s1 = srow + head * 128 + ax * 64 + f0;
            const f32x4 a0 = *(const f32x4*)s1, a1 = *(const f32x4*)(s1 + 4), b0 = *(const f32x4*)(s1 + 32), b1 = *(const f32x4*)(s1 + 36);
            u32x4 w0, w1; w0.x = pkbf(a0[0], b0[0]); w0.y = pkbf(a0[1], b0[1]); w0.z = pkbf(a0[2], b0[2]); w0.w = pkbf(a0[3], b0[3]);
            w1.x = pkbf(a1[0], b1[0]); w1.y = pkbf(a1[1], b1[1]); w1.z = pkbf(a1[2], b1[2]); w1.w = pkbf(a1[3], b1[3]);
            bf16_t* d = drow + head * 128 + ax * 64 + 2 * f0; *(u32x4*)d = w0; *(u32x4*)(d + 8) = w1; } }
}
__device__ __forceinline__ void ffn_fixup(const bf16_t* halo, const float* cw, const float* cbias, bf16_t* A, int gw, int ngw, int lane) {
    for (int task = gw; task < (MTOT / 64) * 2; task += ngw) { const int grp = task >> 1, last = task & 1, row = grp * 64 + (last ? 63 : 0);
        const int seq0 = row < NPR ? (row & ~255) : NPR + ((row - NPR) & ~4095), seqL = row < NPR ? 256 : 4096;
        const bool hasp = row > seq0, hasn = row < seq0 + seqL - 1;
        const bf16_t* hc = halo + (size_t)(grp * 4 + (last ? 3 : 0)) * NUP;
        const bf16_t* hp = last ? halo + (size_t)(grp * 4 + 2) * NUP : halo + (size_t)((grp - 1) * 4 + 3) * NUP;
        const bf16_t* hn = last ? halo + (size_t)((grp + 1) * 4 + 0) * NUP : halo + (size_t)(grp * 4 + 1) * NUP;
        for (int j = 0; j < 11; ++j) { const int cg = j * 512 + lane * 8, cv = DFF + cg;
            float ug[8], uv[8], pg[8], pv[8], ng[8], nv[8]; unpack8(*(const u32x4*)(hc + cg), ug); unpack8(*(const u32x4*)(hc + cv), uv);
#pragma unroll
            for (int e = 0; e < 8; ++e) { pg[e] = 0.f; pv[e] = 0.f; ng[e] = 0.f; nv[e] = 0.f; }
            if (hasp) { unpack8(*(const u32x4*)(hp + cg), pg); unpack8(*(const u32x4*)(hp + cv), pv); }
            if (hasn) { unpack8(*(const u32x4*)(hn + cg), ng); unpack8(*(const u32x4*)(hn + cv), nv); }
            float o[8];
#pragma unroll
            for (int e = 0; e < 8; ++e) { const float gv = cw[cg + e] * pg[e] + cw[NUP + cg + e] * ug[e] + cw[2 * NUP + cg + e] * ng[e] + cbias[cg + e];
                const float vv = cw[cv + e] * pv[e] + cw[NUP + cv + e] * uv[e] + cw[2 * NUP + cv + e] * nv[e] + cbias[cv + e]; o[e] = gv * fsigmoid(gv) * vv; }
            *(u32x4*)(A + (size_t)row * DFF + cg) = pack8(o); }
    }
}

constexpr int SC_LF = 0, SC_SEG = 33792, SC_QT = 35840, SC_KT = 53248, SC_VS = 70656, SC_PL = 107520, SC_ER = 116736;
typedef short v4i16_t __attribute__((ext_vector_type(4)));
__device__ __forceinline__ bf16x8 tr_pair(const LAS unsigned char* p) {
    const v4i16_t a = __builtin_amdgcn_ds_read_tr16_b64_v4i16((LAS v4i16_t*)p), b = __builtin_amdgcn_ds_read_tr16_b64_v4i16((LAS v4i16_t*)(p + 4 * 272));
    return (bf16x8){a[0], a[1], a[2], a[3], b[0], b[1], b[2], b[3]}; }
__device__ __forceinline__ void hgrn_unit(LAS unsigned char* lds, const bf16_t* Qh, const bf16_t* Vh, const bf16_t* LF, bf16_t* Od, const float* S0, float* Sout,
                                          int seqbase, int nch, int h, int dir, int tid, int wave, int lane) {
    int opq = 0; asm volatile("" : "+v"(opq));
    const int g = (lane >> 4) + opq, l16 = lane & 15;
    const int fs = (tid >> 4) + opq, fc = (tid & 15) * 8;
    LAS float* LFs = (LAS float*)(lds + SC_LF); LAS float* SEG = (LAS float*)(lds + SC_SEG);
    LAS float* ER = (LAS float*)(lds + SC_ER); LAS float* EL = ER + 128; LAS float* ELR = ER + 256;
    LAS bf16_t* PL = (LAS bf16_t*)(lds + SC_PL);
    const int trq = (lane & 15) >> 2, trp = lane & 3;
    f32x4 Sacc[8];
#pragma unroll
    for (int mt = 0; mt < 8; ++mt)
#pragma unroll
        for (int i = 0; i < 4; ++i) Sacc[mt][i] = S0 ? S0[(16 * mt + 4 * g + i) * 128 + 16 * wave + l16] : 0.f;
    for (int i = tid; i < 64 * 72 / 2; i += 512) ((LAS unsigned*)(lds + SC_PL))[i] = 0u;
    u32x4 pq[2], pv[2], pl[2];
    { const int c0 = dir ? nch - 1 : 0;
#pragma unroll
      for (int i = 0; i < 2; ++i) { const size_t off = (size_t)(seqbase + 64 * c0 + fs + 32 * i) * DM + h * 128 + fc;
          pq[i] = *(const u32x4*)(Qh + off); pv[i] = *(const u32x4*)(Vh + off); pl[i] = *(const u32x4*)(LF + off); } }
    for (int step = 0; step < nch; ++step) {
        const int cidx = dir ? nch - 1 - step : step; const int R0 = seqbase + 64 * cidx;
        u32x4 cq[2], cv[2], cl[2];
#pragma unroll
        for (int i = 0; i < 2; ++i) { cq[i] = pq[i]; cv[i] = pv[i]; cl[i] = pl[i]; }
#pragma unroll
        for (int i = 0; i < 2; ++i) { LAS float* d = LFs + (fs + 32 * i) * 132 + fc;
            f32x4 a, b; a[0] = f16lo(cl[i].x); a[1] = f16hi(cl[i].x); a[2] = f16lo(cl[i].y); a[3] = f16hi(cl[i].y); b[0] = f16lo(cl[i].z); b[1] = f16hi(cl[i].z); b[2] = f16lo(cl[i].w); b[3] = f16hi(cl[i].w);
            *(LAS f32x4*)d = a; *(LAS f32x4*)(d + 4) = b; }
        if (step + 1 < nch) { const int cn = dir ? cidx - 1 : cidx + 1;
#pragma unroll
            for (int i = 0; i < 2; ++i) { const size_t off = (size_t)(seqbase + 64 * cn + fs + 32 * i) * DM + h * 128 + fc;
                pq[i] = *(const u32x4*)(Qh + off); pv[i] = *(const u32x4*)(Vh + off); pl[i] = *(const u32x4*)(LF + off); } }
        lds_barrier();
        { const int c = tid & 127, seg = tid >> 7; float v[16];
#pragma unroll
          for (int r = 0; r < 16; ++r) v[r] = LFs[(16 * seg + (dir ? 15 - r : r)) * 132 + c];
#pragma unroll
          for (int r = 1; r < 16; ++r) v[r] += v[r - 1];
#pragma unroll
          for (int r = 0; r < 16; ++r) LFs[(16 * seg + (dir ? 15 - r : r)) * 132 + c] = v[r];
          SEG[seg * 128 + c] = v[15]; }
        lds_barrier();
        { const bool hiseg = (fs >> 4) != 0; const int mr = dir ? 32 : 31, lr = dir ? 0 : 63;
#pragma unroll
          for (int hf = 0; hf < 2; ++hf) { const int c4 = fc + 4 * hf;
              const f32x4 T0 = *(const LAS f32x4*)(SEG + c4), T1 = *(const LAS f32x4*)(SEG + 128 + c4), T2 = *(const LAS f32x4*)(SEG + 256 + c4), T3 = *(const LAS f32x4*)(SEG + 384 + c4);
              const f32x4 z4 = {0.f, 0.f, 0.f, 0.f}; f32x4 om, ol, o0, o1;
              if (!dir) { om = T0; ol = T0 + T1 + T2; o0 = hiseg ? T0 : z4; o1 = T0 + T1 + (hiseg ? T2 : z4); }
              else { om = T3; ol = T3 + T2 + T1; o1 = hiseg ? z4 : T3; o0 = T3 + T2 + (hiseg ? z4 : T1); }
              const f32x4 rr = *(const LAS f32x4*)(LFs + mr * 132 + c4) + om;
              if (fs == 0) { const f32x4 bl = *(const LAS f32x4*)(LFs + lr * 132 + c4) + ol;
#pragma unroll
                  for (int e = 0; e < 4; ++e) { ER[c4 + e] = __builtin_amdgcn_exp2f(rr[e]); EL[c4 + e] = __builtin_amdgcn_exp2f(bl[e]); ELR[c4 + e] = __builtin_amdgcn_exp2f(bl[e] - rr[e]); } }
#pragma unroll
              for (int i = 0; i < 2; ++i) { const int s = fs + 32 * i;
                  const f32x4 bb = *(const LAS f32x4*)(LFs + s * 132 + c4) + (i ? o1 : o0);
                  const unsigned qw0 = hf ? cq[i].z : cq[i].x, qw1 = hf ? cq[i].w : cq[i].y, vw0 = hf ? cv[i].z : cv[i].x, vw1 = hf ? cv[i].w : cv[i].y, lw0 = hf ? cl[i].z : cl[i].x, lw1 = hf ? cl[i].w : cl[i].y;
                  const float q[4] = {bflo(qw0), bfhi(qw0), bflo(qw1), bfhi(qw1)}; const float lf[4] = {f16lo(lw0), f16hi(lw0), f16lo(lw1), f16hi(lw1)};
                  float qt[4], kt[4];
#pragma unroll
                  for (int e = 0; e < 4; ++e) { float d = bb[e] - rr[e]; d = fminf(fmaxf(d, -115.f), 115.f); qt[e] = q[e] * __builtin_amdgcn_exp2f(d); kt[e] = (1.f - __builtin_amdgcn_exp2f(lf[e])) * __builtin_amdgcn_exp2f(-d); }
                  u32x2 qw, kw; qw.x = pkbf(qt[0], qt[1]); qw.y = pkbf(qt[2], qt[3]); kw.x = pkbf(kt[0], kt[1]); kw.y = pkbf(kt[2], kt[3]);
                  *(LAS u32x2*)(lds + SC_QT + s * 272 + c4 * 2) = qw; *(LAS u32x2*)(lds + SC_KT + s * 272 + c4 * 2) = kw;
                  u32x2 vw; vw.x = vw0; vw.y = vw1; *(LAS u32x2*)(lds + SC_VS + s * 272 + c4 * 2) = vw; }
              asm volatile("" ::: "memory"); }
        }
        lds_barrier();
        for (int ti_ = wave; ti_ < 10; ti_ += 8) {
            int ti, sj; { int a = ti_ < 1 ? 0 : ti_ < 3 ? 1 : ti_ < 6 ? 2 : 3; int b = ti_ - (a * (a + 1)) / 2; if (!dir) { ti = a; sj = b; } else { ti = 3 - a; sj = 3 - b; } }
            f32x4 p = {0.f, 0.f, 0.f, 0.f};
#pragma unroll
            for (int kk = 0; kk < 4; ++kk) { const bf16x8 xa = *(const LAS bf16x8*)(lds + SC_QT + (16 * ti + l16) * 272 + 64 * kk + 16 * g);
                const bf16x8 yb = *(const LAS bf16x8*)(lds + SC_KT + (16 * sj + l16) * 272 + 64 * kk + 16 * g);
                p = __builtin_amdgcn_mfma_f32_16x16x32_bf16(xa, yb, p, 0, 0, 0); }
#pragma unroll
            for (int i = 0; i < 4; ++i) { const int t = 16 * ti + 4 * g + i, s = 16 * sj + l16; const bool keep = dir ? (s >= t) : (s <= t);
                PL[t * 72 + s] = (bf16_t)(pkbf(keep ? p[i] : 0.f, 0.f) & 0xffffu); }
        }
        asm volatile("" ::: "memory");
        f32x4 oacc[4];
#pragma unroll
        for (int ti = 0; ti < 4; ++ti) oacc[ti] = (f32x4){0.f, 0.f, 0.f, 0.f};
#pragma unroll
        for (int kk = 0; kk < 4; ++kk) {
            const f32x4 e0 = *(const LAS f32x4*)(ER + 32 * kk + 4 * g), e1 = *(const LAS f32x4*)(ER + 32 * kk + 16 + 4 * g);
            const f32x4 s0 = Sacc[2 * kk] * e0, s1 = Sacc[2 * kk + 1] * e1;
            u32x4 yw; yw.x = pkbf(s0[0], s0[1]); yw.y = pkbf(s0[2], s0[3]); yw.z = pkbf(s1[0], s1[1]); yw.w = pkbf(s1[2], s1[3]);
            const bf16x8 yb = __builtin_bit_cast(bf16x8, yw);
#pragma unroll
            for (int ti = 0; ti < 4; ++ti) { const LAS unsigned char* qp = lds + SC_QT + (16 * ti + l16) * 272 + 64 * kk + 8 * g;
                const u32x2 a0 = *(const LAS u32x2*)qp, a1 = *(const LAS u32x2*)(qp + 32);
                u32x4 xw; xw.x = a0.x; xw.y = a0.y; xw.z = a1.x; xw.w = a1.y;
                oacc[ti] = __builtin_amdgcn_mfma_f32_16x16x32_bf16(__builtin_bit_cast(bf16x8, xw), yb, oacc[ti], 0, 0, 0); }
            asm volatile("" ::: "memory");
        }
        bf16x8 vb[2];
#pragma unroll
        for (int ks = 0; ks < 2; ++ks) vb[ks] = tr_pair(lds + SC_VS + (32 * ks + 8 * g + trq) * 272 + (16 * wave + 4 * trp) * 2);
#pragma unroll
        for (int mt = 0; mt < 8; ++mt) { f32x4 d = {0.f, 0.f, 0.f, 0.f};
#pragma unroll
            for (int ks = 0; ks < 2; ++ks) { const bf16x8 xa = tr_pair(lds + SC_KT + (32 * ks + 8 * g + trq) * 272 + (16 * mt + 4 * trp) * 2);
                d = __builtin_amdgcn_mfma_f32_16x16x32_bf16(xa, vb[ks], d, 0, 0, 0); }
            const f32x4 el = *(const LAS f32x4*)(EL + 16 * mt + 4 * g), elr = *(const LAS f32x4*)(ELR + 16 * mt + 4 * g);
            Sacc[mt] = el * Sacc[mt] + elr * d; asm volatile("" ::: "memory"); }
        lds_barrier();
#pragma unroll
        for (int ti = 0; ti < 4; ++ti)
#pragma unroll
            for (int ks = 0; ks < 2; ++ks) { const bf16x8 xa = *(const LAS bf16x8*)(lds + SC_PL + (16 * ti + l16) * 144 + 64 * ks + 16 * g);
                oacc[ti] = __builtin_amdgcn_mfma_f32_16x16x32_bf16(xa, vb[ks], oacc[ti], 0, 0, 0); }
#pragma unroll
        for (int ti = 0; ti < 4; ++ti)
#pragma unroll
            for (int i = 0; i < 4; ++i) Od[(size_t)(R0 + 16 * ti + 4 * g + i) * DM + h * 128 + 16 * wave + l16] = (bf16_t)(pkbf(oacc[ti][i], 0.f) & 0xffffu);
    }
    if (Sout) { int opq2 = 0; asm volatile("" : "+v"(opq2)); Sout += opq2;
#pragma unroll
        for (int mt = 0; mt < 8; ++mt)
#pragma unroll
            for (int i = 0; i < 4; ++i) Sout[(16 * mt + 4 * g + i) * 128 + 16 * wave + l16] = Sacc[mt][i]; }
    __syncthreads();
}


#define XB_TMO      128
#define XB_XCNT(j)  (256  + 64 * (j))
#define XB_XSUB(j)  (1280 + 64 * (j))
#define XB_XGEN(j)  (2304 + 64 * (j))
#define XB_TOP      3328
#define XB_TOPGEN   3392
#define XCD_BAR_WORDS 3456
#define XB_SPIN_CAP (1u << 18)

__device__ __forceinline__ unsigned xb_ld(unsigned* p)              { return __hip_atomic_load(p, __ATOMIC_RELAXED, __HIP_MEMORY_SCOPE_AGENT); }
__device__ __forceinline__ unsigned xb_add(unsigned* p, unsigned v) { return __hip_atomic_fetch_add(p, v, __ATOMIC_RELAXED, __HIP_MEMORY_SCOPE_AGENT); }
__device__ __forceinline__ unsigned xb_xcc_id() { return (unsigned)__builtin_amdgcn_s_getreg((3 << 11) | 20) & 0xFu; }
#define XB_SPIN(cond, bar) do { unsigned _sp = 0; while (cond) { __builtin_amdgcn_s_sleep(1); \
    if ((++_sp & 255u) == 0u) { if (xb_ld(&(bar)[XB_TMO])) break; if (_sp > XB_SPIN_CAP) { atomicAdd(&(bar)[XB_TMO], 1u); break; } } } } while (0)

struct XcdBarrier {
    unsigned* bar; unsigned x;
    volatile LAS unsigned* st;
};

__device__ __forceinline__ XcdBarrier xcd_barrier_post(unsigned* bar, volatile LAS unsigned* st) {
    XcdBarrier b; b.bar = bar; b.x = xb_xcc_id(); b.st = st;
    if (threadIdx.x == 0) (void)xb_add(&bar[XB_XCNT(b.x)], 1u);
    return b;
}
__device__ __forceinline__ void xcd_barrier_complete(unsigned* bar, unsigned x, unsigned& nloc, unsigned& nx) {
    const unsigned G = gridDim.x * gridDim.y * gridDim.z;
    unsigned sum, cnt, mine, sp = 0u;
    for (;;) {
        sum = 0u; cnt = 0u; mine = 0u;
#pragma unroll
        for (unsigned j = 0; j < 16; ++j) { const unsigned c = xb_ld(&bar[XB_XCNT(j)]); sum += c; cnt += (c > 0u) ? 1u : 0u; mine = (j == x) ? c : mine; }
        if (sum == G) break;
        __builtin_amdgcn_s_sleep(1);
        if ((++sp & 255u) == 0u) { if (xb_ld(&bar[XB_TMO])) break; if (sp > XB_SPIN_CAP) { atomicAdd(&bar[XB_TMO], 1u); break; } }
    }
    nloc = mine > 0u ? mine : 1u; nx = cnt > 0u ? cnt : 1u;
}

__device__ __forceinline__ void xcd_barrier(const XcdBarrier& b) {
    asm volatile("s_waitcnt vmcnt(0)" ::: "memory");
    __syncthreads();
    if (threadIdx.x == 0) {
        unsigned* bar = b.bar;
        __builtin_amdgcn_s_waitcnt(0);
        unsigned nloc = b.st[0], nx = b.st[1];
        if (nloc == 0u) { xcd_barrier_complete(bar, b.x, nloc, nx); b.st[0] = nloc; b.st[1] = nx; }
        const unsigned old = xb_add(&bar[XB_XSUB(b.x)], 1u);
        const unsigned gen = old / nloc;
        if (old + 1u == (gen + 1u) * nloc) {
            __builtin_amdgcn_fence(__ATOMIC_RELEASE, "agent");
            asm volatile("s_waitcnt vmcnt(0)" ::: "memory");
            const unsigned og = xb_add(&bar[XB_TOP], 1u);
            const unsigned tg = og / nx;
            if (og + 1u == (tg + 1u) * nx) xb_add(&bar[XB_TOPGEN], 1u);
            else XB_SPIN(xb_ld(&bar[XB_TOPGEN]) == tg, bar);
            __builtin_amdgcn_fence(__ATOMIC_ACQUIRE, "agent");
            xb_add(&bar[XB_XGEN(b.x)], 1u);
            asm volatile("s_waitcnt vmcnt(0)" ::: "memory");
        } else {
            XB_SPIN(xb_ld(&bar[XB_XGEN(b.x)]) == gen, bar);
            __builtin_amdgcn_fence(__ATOMIC_ACQUIRE, "agent");
            asm volatile("s_waitcnt vmcnt(0)" ::: "memory");
        }
    }
    __syncthreads();
}

struct Args { const float* in[24]; float* out; unsigned char* ws; int ph_lo, ph_hi; };
typedef __attribute__((address_space(4))) const unsigned char* kargp_t;
__device__ __forceinline__ const float* KIN(int k) { int z = 0; asm volatile("" : "+s"(z)); kargp_t kp = (kargp_t)__builtin_amdgcn_kernarg_segment_ptr(); return *(const float* const __attribute__((address_space(4)))*)(kp + (size_t)(k + z) * 8); }
__device__ __forceinline__ float* KOUT() { return (float*)KIN(24); }
__device__ __forceinline__ unsigned char* KWS() { return (unsigned char*)KIN(25); }
#define PH_SG int G = gridDim.x, bx = blockIdx.x; asm volatile("" : "+s"(G), "+s"(bx)); const int ngw = G * 8; (void)ngw;
#define PH_IDS PH_SG int tid = threadIdx.x; asm volatile("" : "+v"(tid)); const int lane = tid & 63, wave = __builtin_amdgcn_readfirstlane(tid >> 6); const int gw = bx * 8 + wave; (void)lane; (void)gw;
__global__ void __launch_bounds__(512, 2) mega_fwd(Args a) {
    extern __shared__ __attribute__((aligned(16))) unsigned char lds_[];
    LAS unsigned char* lds = (LAS unsigned char*)lds_;
    cg::grid_group grid = cg::this_grid();
    volatile LAS unsigned* xst = (volatile LAS unsigned*)(lds + LDS_BYTES - 64);
    if (threadIdx.x == 0) { xst[0] = 0u; xst[1] = 0u; }
    __syncthreads();
    XcdBarrier xbar = xcd_barrier_post((unsigned*)(KWS() + WS_BAR), xst);
    bool first_seam = true;
#ifndef PROBE_DUP
#define PROBE_DUP_ 0u
#else
#define PROBE_DUP_ PROBE_DUP
#endif
#ifndef MK_SPLIT
#define MK_SPLIT 0
#endif
#ifndef PH_MASK
#define PH_MASK 0xFFFFFFFFu
#endif
#if MK_SPLIT
    const int ph_lo = a.ph_lo, ph_hi = a.ph_hi; int ph = 0;
#define RUNB(b) (((PH_MASK >> (b)) & 1u) && ph >= ph_lo && ph < ph_hi)
#define SEAM() do { if (ph >= ph_lo && ph + 1 < ph_hi) grid.sync(); ++ph; } while (0)
#else
    (void)a;
#define RUNB(b) ((PH_MASK >> (b)) & 1u)
#define SEAM() do { if (first_seam) { grid.sync(); first_seam = false; } else xcd_barrier(xbar); if ((PROBE_DUP_ >> 10) & 1u) xcd_barrier(xbar); } while (0)
#endif
#define RUN() RUNB(1)
#ifndef PROBE_DUP
#define PROBE_DUP 0u
#endif
#define REP(k) for (int rep_ = 0; rep_ < (((PROBE_DUP >> (k)) & 1u) ? 2 : 1); ++rep_)
#define WSP(off) ((bf16_t*)(KWS() + (off)))

    if (RUNB(0)) REP(3) { PH_IDS
        unsigned char* ws = KWS();
        for (int task = bx; task < 768; task += G) mod_task(task, KIN(2), KIN(6), KIN(7), KIN(8), (float*)(ws + WS_MOD), lds, tid, wave, lane);
        if (bx == G - 1) { float* lbt = (float*)(ws + WS_LB); float* ropet = (float*)(ws + WS_ROPE); const float* lg = KIN(12);
            for (int i = tid; i < 2 * DM; i += 512) { const int d = i / DM, c = i % DM; const float l0 = lg[(d * 2 + 0) * DM + c], l1 = lg[(d * 2 + 1) * DM + c]; lbt[i] = 1.f / (1.f + expf(l1 - l0)); }
            for (int i = tid; i < 2048; i += 512) { const int pos = i >> 5, f = i & 31; const float inv = powf(10000.f, -(float)f / 32.f); const float ang = (float)pos * inv; ropet[2 * i] = cosf(ang); ropet[2 * i + 1] = sinf(ang); }
        }
    }
    SEAM();
    for (int l = 0; l < 2; ++l) {
        if (RUN()) REP(4) { PH_IDS
            unsigned char* ws = KWS(); const float* modl = (const float*)(ws + WS_MOD) + (size_t)l * 9 * NMOD; float* out = KOUT();
            if (l == 0) norm_pass(KIN(0), KIN(1), KIN(9), modl, 0, 1, (bf16_t*)(ws + WS_H), gw, ngw, lane);
            else norm_pass(out, out + (size_t)NPR * DM, KIN(9) + DM, modl, 0, 1, (bf16_t*)(ws + WS_H), gw, ngw, lane);
            transpose_layer(l, ws, lds, gw, ngw, wave, lane);
            if (l == 1) cache_convert(KIN(4), KIN(5), (bf16_t*)(ws + WS_B0) + SZ / 2, (bf16_t*)(ws + WS_B0) + SZ, gw, ngw, lane);
        }
        SEAM();
        if (l == 0) {
            if (RUNB(2)) REP(0) { PH_SG unsigned char* ws = KWS(); pg8::Gemm g{(bf16_t*)(ws + WS_H), (bf16_t*)(ws + WS_WIN), MTOT, 10240, DM}; pg8::StaticOrder S; S.init(MTOT, 10240, G, bx);
                EpiHgrnIn E{(bf16_t*)(ws + WS_B0), (const float*)(ws + WS_LB)};
                pg8::gemm_phase<EpiHgrnIn, pg8::StaticOrder, true, true>(lds, g, S, E); }
            SEAM();
            if (RUNB(3)) REP(1) { PH_IDS
                for (int u = bx; u < 768; u += G) {
                    bf16_t* B0 = WSP(WS_B0); float* out = KOUT();
                    int b, h, dir, seqbase, nch; const float* S0 = nullptr; float* So = nullptr;
                    if (u < 256) { b = u >> 5; h = (u >> 1) & 15; dir = u & 1; seqbase = NPR + b * 4096; nch = 64; S0 = KIN(3) + ((size_t)(b * 2 + dir) * 16 + h) * 16384; }
                    else { const int p = u - 256; b = p >> 5; h = (p >> 1) & 15; dir = p & 1; seqbase = b * 256; nch = 4; So = out + OUT_STATE + ((size_t)(b * 2 + dir) * 16 + h) * 16384; }
                    hgrn_unit(lds, B0, B0 + 3 * (SZ / 2), B0 + (size_t)(1 + dir) * (SZ / 2), (bf16_t*)out + (size_t)dir * MTOT * DM, S0, So, seqbase, nch, h, dir, tid, wave, lane);
                }
            }
            SEAM();
            if (RUN()) REP(7) { PH_IDS bf16_t* B0 = WSP(WS_B0); float* out = KOUT(); hgrn_combine((bf16_t*)out, (bf16_t*)out + (size_t)MTOT * DM, B0 + 2 * SZ, KIN(13), WSP(WS_H), gw, ngw, lane); }
            SEAM();
            if (RUNB(4)) { PH_SG unsigned char* ws = KWS(); pg8::Gemm g{(bf16_t*)(ws + WS_H), (bf16_t*)(ws + WS_WOUT), MTOT, DM, DM}; pg8::StaticOrder S; S.init(MTOT, DM, G, bx);
                EpiResid E{KIN(0), KIN(1), KOUT(), (const float*)(ws + WS_MOD) + 2 * DM};
                pg8::gemm_phase<EpiResid, pg8::StaticOrder, true, true>(lds, g, S, E); }
            SEAM();
        } else {
            if (RUNB(5)) REP(6) { PH_SG unsigned char* ws = KWS(); bf16_t* B0 = (bf16_t*)(ws + WS_B0); float* out = KOUT();
                pg8::Gemm g{(bf16_t*)(ws + WS_H), (bf16_t*)(ws + WS_WIN), MTOT, 6144, DM}; pg8::StaticOrder S; S.init(MTOT, 6144, G, bx);
                EpiAttnIn E{B0, B0 + SZ / 2, B0 + SZ, B0 + 3 * (SZ / 2), B0 + 3 * (SZ / 2) + (size_t)NPR * DM, out + OUT_NK, out + OUT_NV, (const float*)(ws + WS_ROPE)};
                pg8::gemm_phase<EpiAttnIn, pg8::StaticOrder, true, true>(lds, g, S, E); }
            SEAM();
            if (RUNB(6)) REP(2) { PH_SG
                const int vcu = (G % 8 == 0) ? (bx % 8) * (G / 8) + bx / 8 : bx;
                for (int uu = vcu; uu < 4608; uu += G) {
                    bf16_t* B0 = WSP(WS_B0); bf16_t *Qa = B0, *KA = B0 + SZ / 2, *VA = B0 + SZ, *KP = B0 + 3 * (SZ / 2), *VP = KP + (size_t)NPR * DM, *O4 = VP + (size_t)NPR * DM;
                    const att::bf16 *qp, *kp, *vp; att::bf16* op; int seq;
                    if (uu < 4096) { const int qb = uu & 15, half = (uu >> 4) & 1, j = (uu >> 5) & 15, b = uu >> 9; const size_t row = NPR + (size_t)b * 4096 + qb * 256;
                        qp = (const att::bf16*)(Qa + row * DM + j * 128); kp = (const att::bf16*)(KA + (size_t)b * 4608 * DM + j * 128);
                        vp = (const att::bf16*)(VA + (size_t)b * 4608 * DM + (j >> 1) * 256 + half * 128); op = (att::bf16*)(O4 + row * 4096 + (j >> 1) * 512 + (j & 1) * 256 + half * 128); seq = 4608; }
                    else { const int p = uu - 4096, half = p & 1, j = (p >> 1) & 15, b = p >> 5; const size_t row = (size_t)b * 256;
                        qp = (const att::bf16*)(Qa + row * DM + j * 128); kp = (const att::bf16*)(KP + row * DM + j * 128);
                        vp = (const att::bf16*)(VP + row * DM + (j >> 1) * 256 + half * 128); op = (att::bf16*)(O4 + row * 4096 + (j >> 1) * 512 + (j & 1) * 256 + half * 128); seq = 256; }
                    att::attn_dense_body<att::bf16>(qp, kp, vp, op, seq, (char*)lds_);
                    __syncthreads();
                }
            }
            SEAM();
            if (RUN()) REP(7) { PH_IDS bf16_t* B0 = WSP(WS_B0); attn_combine(B0 + 3 * (SZ / 2) + 2 * (size_t)NPR * DM, KIN(16), KIN(17), WSP(WS_H), gw, ngw, lane); }
            SEAM();
            if (RUNB(4)) { PH_SG unsigned char* ws = KWS(); float* out = KOUT(); pg8::Gemm g{(bf16_t*)(ws + WS_H), (bf16_t*)(ws + WS_WOUT), MTOT, DM, DM}; pg8::StaticOrder S; S.init(MTOT, DM, G, bx);
                EpiResid E{out, out + (size_t)NPR * DM, out, (const float*)(ws + WS_MOD) + 9 * NMOD + 2 * DM};
                pg8::gemm_phase<EpiResid, pg8::StaticOrder, true, true>(lds, g, S, E); }
            SEAM();
        }
        if (RUN()) REP(4) { PH_IDS unsigned char* ws = KWS(); float* out = KOUT(); norm_pass(out, out + (size_t)NPR * DM, KIN(10) + l * DM, (const float*)(ws + WS_MOD) + (size_t)l * 9 * NMOD, 3, 4, (bf16_t*)(ws + WS_H), gw, ngw, lane); }
        SEAM();
        if (RUNB(7)) REP(5) { PH_SG unsigned char* ws = KWS(); bf16_t* B0 = (bf16_t*)(ws + WS_B0);
            pg8::Gemm g{(bf16_t*)(ws + WS_H), (bf16_t*)(ws + WS_WUP), MTOT, NUP, DM}; pg8::StaticOrder S; S.init(MTOT, NUP, G, bx);
            EpiFfnUp E{B0, B0 + (size_t)MTOT * DFF, KIN(20) + (size_t)l * 3 * NUP, KIN(21) + (size_t)l * NUP};
            pg8::gemm_phase<EpiFfnUp, pg8::StaticOrder, true, true>(lds, g, S, E); }
        SEAM();
        if (RUN()) REP(8) { PH_IDS bf16_t* B0 = WSP(WS_B0); ffn_fixup(B0 + (size_t)MTOT * DFF, KIN(20) + (size_t)l * 3 * NUP, KIN(21) + (size_t)l * NUP, B0, gw, ngw, lane); }
        SEAM();
        if (RUNB(4)) { PH_SG unsigned char* ws = KWS(); float* out = KOUT(); pg8::Gemm g{(bf16_t*)(ws + WS_B0), (bf16_t*)(ws + WS_WDOWN), MTOT, DM, DFF}; pg8::StaticOrder S; S.init(MTOT, DM, G, bx);
            EpiResid E{out, out + (size_t)NPR * DM, out, (const float*)(ws + WS_MOD) + (size_t)l * 9 * NMOD + 5 * DM};
            pg8::gemm_phase<EpiResid, pg8::StaticOrder, true, true>(lds, g, S, E); }
        SEAM();
    }
    if ((PROBE_DUP >> 12) & 1u) { PH_IDS final_norm(KOUT(), KIN(23), gw, ngw, lane, (float*)(KWS() + WS_B0)); }
    if (RUN()) { PH_IDS final_norm(KOUT(), KIN(23), gw, ngw, lane); }
#undef RUN
#undef RUNB
#undef SEAM
}

constexpr int N_PHASES = 21;
extern "C" void kernel_launch(void* const* d_in, const int* in_sizes, int n_in, void* d_out, int out_size, void* d_ws, size_t ws_size, hipStream_t stream) {
    static int grid = 0;
    if (grid == 0) {
        if (n_in != 24 || ws_size < WS_END) { fprintf(stderr, "kernel_launch: unexpected n_in %d or ws_size %zu (< %zu)\n", n_in, ws_size, (size_t)WS_END); grid = -1; return; }
        int dev = 0, cus = 0, per_cu = 0;
        hipGetDevice(&dev); hipDeviceGetAttribute(&cus, hipDeviceAttributeMultiprocessorCount, dev);
        if (hipFuncSetAttribute((const void*)mega_fwd, hipFuncAttributeMaxDynamicSharedMemorySize, LDS_BYTES) != hipSuccess) { fprintf(stderr, "kernel_launch: hipFuncSetAttribute failed\n"); grid = -1; return; }
        if (hipOccupancyMaxActiveBlocksPerMultiprocessor(&per_cu, (const void*)mega_fwd, 512, LDS_BYTES) != hipSuccess || per_cu < 1) { fprintf(stderr, "kernel_launch: occupancy query says %d\n", per_cu); per_cu = 1; }
        (void)hipGetLastError();
        grid = cus * (per_cu > 1 ? 1 : per_cu);
        if (grid <= 0) grid = 256;
    }
    if (grid < 0) return;
    if (hipMemsetAsync((char*)d_ws, 0, WS_BAR + BAR_BYTES, stream) != hipSuccess) { fprintf(stderr, "kernel_launch: memset failed\n"); return; }
    Args a{};
    for (int i = 0; i < 24; ++i) a.in[i] = (const float*)d_in[i];
    a.out = (float*)d_out; a.ws = (unsigned char*)d_ws;
#if MK_SPLIT
    for (int p = 0; p < N_PHASES; ++p) { a.ph_lo = p; a.ph_hi = p + 1; void* args[] = {&a};
        hipError_t e = hipLaunchCooperativeKernel((const void*)mega_fwd, dim3(grid), dim3(512), args, LDS_BYTES, stream);
        if (e != hipSuccess) { fprintf(stderr, "launch %d failed: %s\n", p, hipGetErrorString(e)); break; } }
#else
    a.ph_lo = 0; a.ph_hi = N_PHASES;
    void* args[] = {&a};
    hipError_t e = hipLaunchCooperativeKernel((const void*)mega_fwd, dim3(grid), dim3(512), args, LDS_BYTES, stream);
    if (e != hipSuccess) fprintf(stderr, "cooperative launch failed: %s (grid %d)\n", hipGetErrorString(e), grid);
#endif
}
```

```cpp
#include <hip/hip_runtime.h>
#include <hip/hip_bf16.h>
#include <hip/hip_cooperative_groups.h>
#include <cstdio>
#include <cstdint>
namespace cg = cooperative_groups;
namespace pg8 {
#define PG8_LAS __attribute__((address_space(3)))
typedef unsigned short bf16_t;
typedef short bf16x8 __attribute__((ext_vector_type(8)));
typedef float f32x4 __attribute__((ext_vector_type(4)));
typedef unsigned u32x4 __attribute__((ext_vector_type(4)));
constexpr int BM = 256, BK = 64, HALF = 128, HTB = HALF * BK * 2  , STAGE_BYTES = 8 * HTB, NXCD = 8, WGM = 4;

__host__ __device__ __forceinline__ int lds_byte(int r, int c) { const int st = (r >> 4) * 2 + (c >> 5), rr = r & 15, cc = c & 31, ob = rr * 64 + cc * 2; return st * 1024 + (ob ^ (((ob >> 9) & 1) << 5)); }
__host__ __device__ __forceinline__ void stage_rc(int b, int& R, int& C) { const int st = b / 1024, sb = b % 1024, swz = sb ^ (((sb >> 9) & 1) << 5); R = (st >> 1) * 16 + swz / 64; C = (st & 1) * 32 + (swz % 64) / 2; }
__host__ __device__ __forceinline__ int perm32(int rho) { const int n = rho >> 4, i = rho & 15; return 8 * (i >> 2) + 4 * n + (i & 3); }

struct Unit { int pm, pn; };
struct Gemm { const bf16_t* A; const bf16_t* Bt; int M, N, K; };

struct StaticOrder {
    int nM, nN, nwg, G, c;
    __host__ __device__ void init(int M, int N, int G_, int c_) { nM = M / BM; nN = N / BM; nwg = nM * nN; G = G_; c = c_; }
    __host__ __device__ bool next(int i, Unit& u) const {
        const long L = (long)i * G + c; if (L >= nwg) return false;
        int wgid = (int)L; { const int q = nwg / NXCD, r = nwg % NXCD, xcd = wgid % NXCD, off = wgid / NXCD; wgid = (xcd < r ? xcd * (q + 1) : r * (q + 1) + (xcd - r) * q) + off; }
        const int nig = WGM * nN, gid = wgid / nig, fm = gid * WGM, gsz = (nM - fm) < WGM ? (nM - fm) : WGM;
        u.pm = fm + ((wgid % nig) % gsz); u.pn = (wgid % nig) / gsz; return true;
    }
    __device__ __forceinline__ void a_ready(const Unit&) const {}
    __device__ __forceinline__ void done(const Unit&) const {}
};

__device__ __forceinline__ unsigned cvt_pk_bf16(float lo, float hi) { unsigned r; asm volatile("v_cvt_pk_bf16_f32 %0, %1, %2" : "=v"(r) : "v"(lo), "v"(hi)); return r; }
template <class Epi, class Sched, bool ALIGN_EPI = false, bool SP2 = false>
__device__ __forceinline__ void gemm_phase(PG8_LAS unsigned char* lds, const Gemm g, const Sched& S, const Epi& E) {
    int tid_ = threadIdx.x; asm volatile("" : "+v"(tid_));
    const int tid = tid_, wid = __builtin_amdgcn_readfirstlane(tid >> 6), lane = tid & 63, wr = wid >> 2, wc = wid & 3, fr = lane & 15, fq = lane >> 4;
    const int K = g.K, nt = K / BK;
    unsigned voffA[2], voffB[2];
#pragma unroll
    for (int i = 0; i < 2; ++i) { int R, C; stage_rc(tid * 16 + i * 8192, R, C); const int Rb = Epi::PERM ? ((R & ~31) + perm32(R & 31)) : R;
        voffA[i] = (unsigned)(R * K + C) * 2u; voffB[i] = (unsigned)(Rb * K + C) * 2u; }
    const size_t kstep = (size_t)(BK * 2);
    const size_t hstep = (size_t)HALF * K * 2;
    const size_t tstep = 2 * hstep;
    const unsigned ldsw = (unsigned)wid * 1024u;
    const int aoff = lds_byte(wr * 64 + fr, fq * 8), boff = lds_byte(wc * 32 + fr, fq * 8);
#define PG8_SA(b, h) (((b) * 2 + (h)) * HTB)
#define PG8_SB(b, h) ((4 + (b) * 2 + (h)) * HTB)
#define PG8_STAGE(bufoff, gbase, voff) do { _Pragma("unroll") for (int _i = 0; _i < 2; ++_i) \
        __builtin_amdgcn_global_load_lds((const unsigned*)((const char*)(gbase) + (voff)[_i]), (PG8_LAS unsigned*)(lds + (bufoff) + ldsw + _i * 8192), 16, 0, 0); } while (0)
#define PG8_LDA(dst, b, h) do { _Pragma("unroll") for (int m = 0; m < 4; ++m) _Pragma("unroll") for (int k = 0; k < 2; ++k) dst[m][k] = *(const PG8_LAS bf16x8*)(lds + PG8_SA(b, h) + aoff + m * 2048 + k * 1024); } while (0)
#define PG8_LDB(dst, b, h) do { _Pragma("unroll") for (int n = 0; n < 2; ++n) _Pragma("unroll") for (int k = 0; k < 2; ++k) dst[n][k] = *(const PG8_LAS bf16x8*)(lds + PG8_SB(b, h) + boff + n * 2048 + k * 1024); } while (0)
#define PG8_MMA(ai, bj, At, Bt) do { __builtin_amdgcn_s_setprio(1); _Pragma("unroll") for (int m = 0; m < 4; ++m) _Pragma("unroll") for (int n = 0; n < 2; ++n) _Pragma("unroll") for (int k = 0; k < 2; ++k) \
        acc[ai][bj][m][n] = __builtin_amdgcn_mfma_f32_16x16x32_bf16(Bt[n][k], At[m][k], acc[ai][bj][m][n], 0, 0, 0); __builtin_amdgcn_s_setprio(0); } while (0)
#define PG8_WAIT_V(n) asm volatile("s_waitcnt vmcnt(" #n ")" ::: "memory")
#define PG8_WAIT_L(n) asm volatile("s_waitcnt lgkmcnt(" #n ")" ::: "memory")
#define PG8_BAR __builtin_amdgcn_s_barrier()
#define PG8_SCHED __builtin_amdgcn_sched_barrier(0)
    Unit cur, nxt; int ui = 0;
    if (!S.next(0, cur)) return;
    f32x4 acc[2][2][4][2];
#pragma unroll
    for (int a = 0; a < 2; ++a)
#pragma unroll
        for (int b = 0; b < 2; ++b)
#pragma unroll
            for (int m = 0; m < 4; ++m)
#pragma unroll
                for (int n = 0; n < 2; ++n) acc[a][b][m][n] = (f32x4){0.f, 0.f, 0.f, 0.f};
    bf16x8 At[4][2], B0[2][2], B1[2][2];
    const char* cA = (const char*)g.A + (size_t)cur.pm * tstep; const char* cB = (const char*)g.Bt + (size_t)cur.pn * tstep;
    S.a_ready(cur);
    if constexpr (SP2) {
        PG8_STAGE(PG8_SB(0, 0), cB, voffB); PG8_STAGE(PG8_SB(0, 1), cB + hstep, voffB); PG8_STAGE(PG8_SA(0, 0), cA, voffA); PG8_STAGE(PG8_SA(0, 1), cA + hstep, voffA);
        if (wr == 1) PG8_BAR;
        PG8_WAIT_V(2); PG8_BAR;
        PG8_STAGE(PG8_SB(1, 0), cB + kstep, voffB); PG8_STAGE(PG8_SA(1, 0), cA + kstep, voffA); PG8_STAGE(PG8_SB(1, 1), cB + hstep + kstep, voffB);
        PG8_WAIT_V(6); PG8_BAR;
    } else {
        PG8_STAGE(PG8_SB(0, 0), cB, voffB); PG8_STAGE(PG8_SA(0, 0), cA, voffA); PG8_STAGE(PG8_SB(0, 1), cB + hstep, voffB); PG8_STAGE(PG8_SA(0, 1), cA + hstep, voffA);
        if (wr == 1) PG8_BAR;
        PG8_WAIT_V(4); PG8_BAR;
        PG8_STAGE(PG8_SB(1, 0), cB + kstep, voffB); PG8_STAGE(PG8_SA(1, 0), cA + kstep, voffA); PG8_STAGE(PG8_SB(1, 1), cB + hstep + kstep, voffB);
        PG8_WAIT_V(6); PG8_BAR;
    }
    for (;;) {
        const bool has_next = S.next(ui + 1, nxt);
        const char* nA = has_next ? (const char*)g.A + (size_t)nxt.pm * tstep : cA; const char* nB = has_next ? (const char*)g.Bt + (size_t)nxt.pn * tstep : cB;
        for (int t = 0; t < nt; t += 2) {
            const bool last = (t == nt - 2);
            const char* a1 = cA + (size_t)(t + 1) * kstep;
            const char* a2 = last ? nA : cA + (size_t)(t + 2) * kstep; const char* b2 = last ? nB : cB + (size_t)(t + 2) * kstep;
            const char* a3 = a2 + kstep; const char* b3 = b2 + kstep;
            if (last && has_next) S.a_ready(nxt);
            if constexpr (SP2) {
            PG8_LDB(B0, 0, 0); PG8_LDB(B1, 0, 1); PG8_SCHED; PG8_LDA(At, 0, 0); PG8_STAGE(PG8_SA(1, 1), a1 + hstep, voffA);
            PG8_WAIT_V(8); PG8_WAIT_L(0); PG8_BAR; PG8_MMA(0, 0, At, B0); PG8_MMA(0, 1, At, B1); PG8_BAR; PG8_SCHED;
            PG8_LDA(At, 0, 1); PG8_STAGE(PG8_SB(0, 0), b2, voffB); PG8_STAGE(PG8_SB(0, 1), b2 + hstep, voffB); PG8_STAGE(PG8_SA(0, 0), a2, voffA);
            PG8_WAIT_V(8); PG8_WAIT_L(0); PG8_BAR; PG8_MMA(1, 0, At, B0); PG8_MMA(1, 1, At, B1); PG8_BAR; PG8_SCHED;
            PG8_LDB(B0, 1, 0); PG8_LDB(B1, 1, 1); PG8_SCHED; PG8_LDA(At, 1, 0); PG8_STAGE(PG8_SA(0, 1), a2 + hstep, voffA);
            PG8_WAIT_V(8); PG8_WAIT_L(0); PG8_BAR; PG8_MMA(0, 0, At, B0); PG8_MMA(0, 1, At, B1); PG8_BAR; PG8_SCHED;
            PG8_LDA(At, 1, 1); PG8_STAGE(PG8_SB(1, 0), b3, voffB); PG8_STAGE(PG8_SB(1, 1), b3 + hstep, voffB); PG8_STAGE(PG8_SA(1, 0), a3, voffA);
            PG8_WAIT_V(8); PG8_WAIT_L(0); PG8_BAR; PG8_MMA(1, 0, At, B0); PG8_MMA(1, 1, At, B1); PG8_BAR; PG8_SCHED;
            } else {
            PG8_LDB(B0, 0, 0); PG8_SCHED; PG8_LDA(At, 0, 0); PG8_STAGE(PG8_SA(1, 1), a1 + hstep, voffA);
            PG8_WAIT_L(8); PG8_BAR; PG8_WAIT_L(0); PG8_MMA(0, 0, At, B0); PG8_BAR; PG8_SCHED;
            PG8_LDB(B1, 0, 1); PG8_STAGE(PG8_SB(0, 0), b2, voffB);
            PG8_BAR; PG8_WAIT_L(0); PG8_MMA(0, 1, At, B1); PG8_BAR;
            PG8_LDA(At, 0, 1); PG8_STAGE(PG8_SA(0, 0), a2, voffA);
            PG8_BAR; PG8_WAIT_L(0); PG8_MMA(1, 0, At, B0); PG8_BAR; PG8_SCHED;
            PG8_STAGE(PG8_SB(0, 1), b2 + hstep, voffB);
            PG8_WAIT_V(6); PG8_BAR; PG8_MMA(1, 1, At, B1); PG8_BAR;
            PG8_LDB(B0, 1, 0); PG8_SCHED; PG8_LDA(At, 1, 0); PG8_STAGE(PG8_SA(0, 1), a2 + hstep, voffA);
            PG8_WAIT_L(8); PG8_BAR; PG8_WAIT_L(0); PG8_MMA(0, 0, At, B0); PG8_BAR; PG8_SCHED;
            PG8_LDB(B1, 1, 1); PG8_STAGE(PG8_SB(1, 0), b3, voffB);
            PG8_BAR; PG8_WAIT_L(0); PG8_MMA(0, 1, At, B1); PG8_BAR;
            PG8_LDA(At, 1, 1); PG8_STAGE(PG8_SA(1, 0), a3, voffA);
            PG8_BAR; PG8_WAIT_L(0); PG8_MMA(1, 0, At, B0); PG8_BAR; PG8_SCHED;
            PG8_STAGE(PG8_SB(1, 1), b3 + hstep, voffB);
            PG8_WAIT_V(6); PG8_BAR; PG8_MMA(1, 1, At, B1); PG8_BAR;
            }
        }
        if constexpr (ALIGN_EPI) { if (wr == 0) PG8_BAR; }
        if constexpr (!Epi::AFTER_DRAIN) { E(acc, cur, wr, wc, fr, fq); S.done(cur); }
        if (!has_next) break;
#pragma unroll
        for (int a = 0; a < 2; ++a)
#pragma unroll
            for (int b = 0; b < 2; ++b)
#pragma unroll
                for (int m = 0; m < 4; ++m)
#pragma unroll
                    for (int n = 0; n < 2; ++n) acc[a][b][m][n] = (f32x4){0.f, 0.f, 0.f, 0.f};
        cur = nxt; cA = nA; cB = nB; ++ui;
        if constexpr (ALIGN_EPI) { if (wr == 1) PG8_BAR; }
    }
    PG8_WAIT_V(0);
    if constexpr (!ALIGN_EPI) { if (wr == 0) PG8_BAR; }
    PG8_BAR;
    if constexpr (Epi::AFTER_DRAIN) { E.fused(acc, cur, wr, wc, fr, fq, lds, wid, lane); S.done(cur); }
#undef PG8_SA
#undef PG8_SB
#undef PG8_STAGE
#undef PG8_LDA
#undef PG8_LDB
#undef PG8_MMA
#undef PG8_WAIT_V
#undef PG8_WAIT_L
#undef PG8_BAR
#undef PG8_SCHED
}
}

namespace att {
using bf16 = __hip_bfloat16;
constexpr int   D = 128, NW = 8, QBLK = 32, KVBLK = 64;
constexpr float SCALE = 0.088388347648318440f;
constexpr float THR = 8.f;
constexpr int SDEPTH = 2;
constexpr int LDQ = 2048, LDK = 2048, LDO = 4096;
constexpr size_t SHM_V = KVBLK * D * 2, SHM_K = KVBLK * D * 2, SHM_ATTN = 2 * SHM_V + 2 * SHM_K + NW * 64 * 4;
using bf16x8 = __attribute__((ext_vector_type(8))) short;
using s16x4  = __attribute__((ext_vector_type(4))) short;
using f32x16 = __attribute__((ext_vector_type(16))) float;
using f32x8  = __attribute__((ext_vector_type(8))) float;
using u32x4  = __attribute__((ext_vector_type(4))) unsigned;
#define KSWZ(row, colB) ((row) * 256 + ((colB) ^ (((row) & 7) << 4)))
#define SBAR() __builtin_amdgcn_sched_barrier(0)
__device__ __forceinline__ int crow(int r, int hi) { return (r & 3) + 8 * (r >> 2) + 4 * hi; }
__device__ __forceinline__ unsigned cvtpk(float lo, float hi) {
  unsigned r; asm volatile("v_cvt_pk_bf16_f32 %0, %1, %2" : "=v"(r) : "v"(lo), "v"(hi)); return r;
}
template <typename TIn> struct Stage;
template <> struct Stage<bf16>  { using T = bf16x8;
  __device__ static __forceinline__ T ld8(const bf16* p) { return *reinterpret_cast<const bf16x8*>(p); }
  __device__ static __forceinline__ bf16x8 tobf(T x) { return x; } };
template <> struct Stage<float> { using T = f32x8;
  __device__ static __forceinline__ T ld8(const float* p) { return *reinterpret_cast<const f32x8*>(p); }
  __device__ static __forceinline__ bf16x8 tobf(T x) {
    u32x4 w = {cvtpk(x[0], x[1]), cvtpk(x[2], x[3]), cvtpk(x[4], x[5]), cvtpk(x[6], x[7])}; return *reinterpret_cast<bf16x8*>(&w); } };

__device__ __forceinline__ void partialSM(f32x16& p0, f32x16& p1, float& m_reg, float& mn, float& alpha) {
  constexpr float C = SCALE * 1.4426950408889634f;
  float pmax = p0[0]; for (int r = 1; r < 16; ++r) pmax = fmaxf(pmax, p0[r]); for (int r = 0; r < 16; ++r) pmax = fmaxf(pmax, p1[r]);
  { auto rr = __builtin_amdgcn_permlane32_swap(__float_as_uint(pmax), __float_as_uint(pmax), false, false);
    pmax = fmaxf(__uint_as_float(rr[0]), __uint_as_float(rr[1])); }
  if (__builtin_expect(__all(pmax - m_reg <= THR / SCALE), 1)) { mn = m_reg; alpha = 1.f; }
  else { mn = fmaxf(m_reg, pmax); alpha = __builtin_amdgcn_exp2f((m_reg - mn) * C); m_reg = mn; }
  float mnC = -mn * C;
  for (int r = 0; r < 16; ++r) p0[r] = fmaf(p0[r], C, mnC); for (int r = 0; r < 16; ++r) p1[r] = fmaf(p1[r], C, mnC);
  for (int r = 0; r < 16; ++r) p0[r] = __builtin_amdgcn_exp2f(p0[r]);
}
__device__ __forceinline__ void finishSM(f32x16& p0, f32x16& p1, float alpha, float& l_reg, bf16x8& pa0, bf16x8& pa1, bf16x8& pa2, bf16x8& pa3) {
  for (int r = 0; r < 16; ++r) p1[r] = __builtin_amdgcn_exp2f(p1[r]);
  float ps = 0; for (int r = 0; r < 16; ++r) ps += p0[r]; for (int r = 0; r < 16; ++r) ps += p1[r];
  { auto rr = __builtin_amdgcn_permlane32_swap(__float_as_uint(ps), __float_as_uint(ps), false, false);
    ps = __uint_as_float(rr[0]) + __uint_as_float(rr[1]); }
  l_reg = l_reg * alpha + ps;
#define PK4(P, BASE, OUT) do { unsigned a0 = cvtpk(P[BASE + 0], P[BASE + 1]), a1 = cvtpk(P[BASE + 2], P[BASE + 3]);   \
    unsigned b0 = cvtpk(P[BASE + 4], P[BASE + 5]), b1 = cvtpk(P[BASE + 6], P[BASE + 7]);                              \
    auto r0 = __builtin_amdgcn_permlane32_swap(a0, b0, false, false); auto r1 = __builtin_amdgcn_permlane32_swap(a1, b1, false, false); \
    u32x4 w = {r0[0], r1[0], r0[1], r1[1]}; OUT = *reinterpret_cast<bf16x8*>(&w); } while (0)
  PK4(p0, 0, pa0); PK4(p0, 8, pa1); PK4(p1, 0, pa2); PK4(p1, 8, pa3);
#undef PK4
}
__device__ __forceinline__ void qkt(f32x16& p0, f32x16& p1, const bf16* Ks, const bf16x8* qr, int r32, int hi) {
  p0 = f32x16{}; p1 = f32x16{};
  for (int d0 = 0; d0 < 8; ++d0) { int cb = (d0 * 16 + hi * 8) * 2;
    bf16x8 b0 = *reinterpret_cast<const bf16x8*>((const char*)Ks + KSWZ(r32, cb));
    bf16x8 b1 = *reinterpret_cast<const bf16x8*>((const char*)Ks + KSWZ(32 + r32, cb));
    p0 = __builtin_amdgcn_mfma_f32_32x32x16_bf16(b0, qr[d0], p0, 0, 0, 0);
    p1 = __builtin_amdgcn_mfma_f32_32x32x16_bf16(b1, qr[d0], p1, 0, 0, 0); }
}
__device__ __forceinline__ int v_st(int k, int c) { const int kk = (k & ~0xC) | ((k & 4) << 1) | ((k & 8) >> 1); return ((kk >> 3) * 4 + (c >> 5)) * 512 + ((kk & 7) * 32 + (c & 31)) * 2; }
__device__ __forceinline__ int v_rd_base(int lane) { return ((lane & 3) << 3) | (((lane >> 2) & 3) << 6) | (((lane >> 4) & 1) << 5) | (((lane >> 5) & 1) << 8); }
constexpr int v_rd_off(int d0, int ks, int half) { return d0 * 512 + ks * 4096 + half * 2048; }
template <int OFF> __device__ __forceinline__ s16x4 tr_read(int vb) {
  s16x4 r; asm volatile("ds_read_b64_tr_b16 %0, %1 offset:%2" : "=&v"(r) : "v"(vb), "i"(OFF) : "memory"); return r;
}
template <int D0> __device__ __forceinline__ void pv_one(f32x16& od, int vb, bf16x8 pa0, bf16x8 pa1, bf16x8 pa2, bf16x8 pa3) {
  const s16x4 l0 = tr_read<v_rd_off(D0, 0, 0)>(vb), h0 = tr_read<v_rd_off(D0, 0, 1)>(vb), l1 = tr_read<v_rd_off(D0, 1, 0)>(vb), h1 = tr_read<v_rd_off(D0, 1, 1)>(vb);
  const s16x4 l2 = tr_read<v_rd_off(D0, 2, 0)>(vb), h2 = tr_read<v_rd_off(D0, 2, 1)>(vb), l3 = tr_read<v_rd_off(D0, 3, 0)>(vb), h3 = tr_read<v_rd_off(D0, 3, 1)>(vb);
  asm volatile("s_waitcnt lgkmcnt(0)" ::: "memory"); SBAR();
#define PK(L, H) (bf16x8){L[0], L[1], L[2], L[3], H[0], H[1], H[2], H[3]}
  od = __builtin_amdgcn_mfma_f32_32x32x16_bf16(pa0, PK(l0, h0), od, 0, 0, 0);
  od = __builtin_amdgcn_mfma_f32_32x32x16_bf16(pa1, PK(l1, h1), od, 0, 0, 0);
  od = __builtin_amdgcn_mfma_f32_32x32x16_bf16(pa2, PK(l2, h2), od, 0, 0, 0);
  od = __builtin_amdgcn_mfma_f32_32x32x16_bf16(pa3, PK(l3, h3), od, 0, 0, 0);
#undef PK
}
__device__ __forceinline__ void pv_d0(f32x16* o, int vb, bf16x8 pa0, bf16x8 pa1, bf16x8 pa2, bf16x8 pa3) {
  pv_one<0>(o[0], vb, pa0, pa1, pa2, pa3); pv_one<1>(o[1], vb, pa0, pa1, pa2, pa3); pv_one<2>(o[2], vb, pa0, pa1, pa2, pa3); pv_one<3>(o[3], vb, pa0, pa1, pa2, pa3);
}


__device__ __forceinline__ void att_lds_barrier() { asm volatile("s_waitcnt lgkmcnt(0)\n\ts_barrier" ::: "memory"); }
template <typename TQ>
__device__ __forceinline__ void attn_dense_body(const TQ* __restrict__ Qb, const bf16* __restrict__ Kh, const bf16* __restrict__ Vh,
                                                bf16* __restrict__ Ob, int seq, char* lds) {
  using St = Stage<bf16>; using SQ = Stage<TQ>;
  int tid_ = threadIdx.x; asm volatile("" : "+v"(tid_));
  const int tid = tid_, wid = tid >> 6, lane = tid & 63, r32 = lane & 31, hi = lane >> 5;
  bf16* V_lds = (bf16*)lds; bf16* K_lds = (bf16*)(lds + 2 * SHM_V);
  float* ws = (float*)(lds + 2 * SHM_V + 2 * SHM_K) + wid * 64; float* li_l = ws; float* al_l = ws + 32;
  float m_reg = -1e30f, l_reg = 0; f32x16 o[4] = {}; bf16x8 qr[8];
  const TQ* Qw = Qb + (long)(wid * QBLK + r32) * LDQ + hi * 8;
#pragma unroll
  for (int d0 = 0; d0 < 8; ++d0) qr[d0] = SQ::tobf(SQ::ld8(Qw + d0 * 16));
  const int sr = tid >> 4, sc = (tid & 15) * 8, vst0 = v_st(sr, sc), vst1 = v_st(32 + sr, sc);
  const int vb0 = (int)(uintptr_t)V_lds + v_rd_base(lane);
  struct { typename St::T vs0, vs1, ks0, ks1; } sr_[SDEPTH];
#define SLOAD(i, k0) do { sr_[i].vs0 = St::ld8(&Vh[(long)((k0) + sr) * LDK + sc]); sr_[i].vs1 = St::ld8(&Vh[(long)((k0) + 32 + sr) * LDK + sc]); \
    sr_[i].ks0 = St::ld8(&Kh[(long)((k0) + sr) * LDK + sc]); sr_[i].ks1 = St::ld8(&Kh[(long)((k0) + 32 + sr) * LDK + sc]); } while (0)
#define SWRITE(b, i) do { *(bf16x8*)((char*)V_lds + (b) * SHM_V + vst0) = St::tobf(sr_[i].vs0);          \
    *(bf16x8*)((char*)V_lds + (b) * SHM_V + vst1) = St::tobf(sr_[i].vs1); int kc = sc * 2;               \
    *(bf16x8*)((char*)K_lds + (b) * SHM_K + KSWZ(sr, kc)) = St::tobf(sr_[i].ks0);                       \
    *(bf16x8*)((char*)K_lds + (b) * SHM_K + KSWZ(32 + sr, kc)) = St::tobf(sr_[i].ks1); } while (0)
#define SWAIT() do { if constexpr (SDEPTH == 2) asm volatile("s_waitcnt vmcnt(4)" ::: "memory"); else asm volatile("s_waitcnt vmcnt(0)" ::: "memory"); } while (0)
#define RESC(a) do { if (__any((a) < 1.f)) { if (hi == 0) al_l[r32] = (a); asm volatile("s_waitcnt lgkmcnt(0)" ::: "memory"); \
    for (int d = 0; d < 4; ++d) for (int r = 0; r < 16; ++r) o[d][r] *= al_l[crow(r, hi)]; } } while (0)
  f32x16 pA0, pA1, pB0, pB1; float mnA, mnB, alA, alB; bf16x8 pa0, pa1, pa2, pa3; const int NT = seq / KVBLK;
  constexpr int SE = 0, SO = SDEPTH - 1;
  SLOAD(SE, 0); asm volatile("s_waitcnt vmcnt(0)" ::: "memory"); SWRITE(0, SE); att_lds_barrier();
  qkt(pA0, pA1, K_lds, qr, r32, hi); partialSM(pA0, pA1, m_reg, mnA, alA);
  SLOAD(SO, KVBLK); if constexpr (SDEPTH == 2) { if (2 < NT) SLOAD(SE, 2 * KVBLK); }
  SWAIT(); SWRITE(1, SO); att_lds_barrier();
  for (int j = 1; j + 1 < NT; j += 2) {
    SBAR(); qkt(pB0, pB1, (bf16*)((char*)K_lds + SHM_K), qr, r32, hi);
    finishSM(pA0, pA1, alA, l_reg, pa0, pa1, pa2, pa3); SBAR();
    SLOAD(SO, (j + SDEPTH) * KVBLK); SBAR();
    pv_d0(o, vb0, pa0, pa1, pa2, pa3); partialSM(pB0, pB1, m_reg, mnB, alB);
    att_lds_barrier(); SWAIT(); SWRITE(0, SE);
    RESC(alB); att_lds_barrier();
    SBAR(); qkt(pA0, pA1, K_lds, qr, r32, hi);
    finishSM(pB0, pB1, alB, l_reg, pa0, pa1, pa2, pa3); SBAR();
    if (SDEPTH == 1 || j + 3 < NT) SLOAD(SE, (j + 1 + SDEPTH) * KVBLK); SBAR();
    pv_d0(o, vb0 + (int)SHM_V, pa0, pa1, pa2, pa3); partialSM(pA0, pA1, m_reg, mnA, alA);
    att_lds_barrier(); SWAIT(); SWRITE(1, SO);
    RESC(alA); att_lds_barrier();
  }
  SBAR(); qkt(pB0, pB1, (bf16*)((char*)K_lds + SHM_K), qr, r32, hi);
  finishSM(pA0, pA1, alA, l_reg, pa0, pa1, pa2, pa3); SBAR();
  pv_d0(o, vb0, pa0, pa1, pa2, pa3); partialSM(pB0, pB1, m_reg, mnB, alB);
  att_lds_barrier(); RESC(alB);
  finishSM(pB0, pB1, alB, l_reg, pa0, pa1, pa2, pa3); SBAR();
  pv_d0(o, vb0 + (int)SHM_V, pa0, pa1, pa2, pa3);
  if (hi == 0) li_l[r32] = l_reg; asm volatile("s_waitcnt lgkmcnt(0)" ::: "memory");
  float rli[16];
#pragma unroll
  for (int r = 0; r < 16; ++r) rli[r] = __builtin_amdgcn_rcpf(li_l[crow(r, hi)]);
  bf16* Ow = Ob + (long)(wid * QBLK) * LDO;
#pragma unroll
  for (int r = 0; r < 16; ++r) { int orow = crow(r, hi);
    for (int d0 = 0; d0 < 4; ++d0) Ow[(long)orow * LDO + d0 * 32 + r32] = __float2bfloat16(o[d0][r] * rli[r]); }
#undef SLOAD
#undef SWRITE
#undef SWAIT
#undef RESC
}
#undef KSWZ
#undef SBAR
}

#define LAS __attribute__((address_space(3)))
typedef unsigned short bf16_t;
typedef float f32x4 __attribute__((ext_vector_type(4)));
typedef unsigned u32x4 __attribute__((ext_vector_type(4)));
typedef unsigned u32x2 __attribute__((ext_vector_type(2)));
typedef short bf16x8 __attribute__((ext_vector_type(8)));
typedef short s16x4v __attribute__((ext_vector_type(4)));

constexpr int DM = 2048, NPR = 4096, MTOT = 36864, DFF = 5632, NUP = 11264, NMOD = 12288;
constexpr float EPS = 1e-6f;
constexpr size_t MiB = (size_t)1 << 20;
constexpr size_t WS_MOD = 0, WS_LB = 1 * MiB, WS_ROPE = 1 * MiB + 65536, WS_BAR = 1 * MiB + 131072, BAR_BYTES = 16384;
constexpr size_t WS_WUP = 2 * MiB, WS_WDOWN = 46 * MiB, WS_WOUT = 68 * MiB, WS_WIN = 76 * MiB;
constexpr size_t WS_H = 116 * MiB, WS_B0 = 260 * MiB, SZ = 144 * MiB;
constexpr size_t WS_END = 1012 * MiB;
constexpr size_t OUT_STATE = (size_t)MTOT * DM, OUT_NK = OUT_STATE + 8388608, OUT_NV = OUT_NK + 8388608;
constexpr int LDS_BYTES = 147456;

__device__ __forceinline__ float fsigmoid(float z) { return __builtin_amdgcn_rcpf(1.f + __expf(-z)); }
__device__ __forceinline__ unsigned pkbf(float lo, float hi) { return pg8::cvt_pk_bf16(lo, hi); }
__device__ __forceinline__ float bflo(unsigned w) { return __uint_as_float(w << 16); }
__device__ __forceinline__ float bfhi(unsigned w) { return __uint_as_float(w & 0xffff0000u); }
typedef _Float16 h16x2 __attribute__((ext_vector_type(2)));
__device__ __forceinline__ unsigned pk_f16(float a, float b) { h16x2 v = {(_Float16)a, (_Float16)b}; return __builtin_bit_cast(unsigned, v); }
__device__ __forceinline__ float f16lo(unsigned w) { h16x2 v = __builtin_bit_cast(h16x2, w); return (float)v.x; }
__device__ __forceinline__ float f16hi(unsigned w) { h16x2 v = __builtin_bit_cast(h16x2, w); return (float)v.y; }
__device__ __forceinline__ float shx(float v, int o, int lane) { return __builtin_bit_cast(float, __builtin_amdgcn_ds_bpermute((lane ^ o) << 2, __builtin_bit_cast(int, v))); }
__device__ __forceinline__ float wave_sum(float v, int lane) {
#pragma unroll
    for (int o = 1; o < 64; o <<= 1) v += shx(v, o, lane);
    return v;
}
__device__ __forceinline__ void lds_barrier() { asm volatile("s_waitcnt lgkmcnt(0)\n\ts_barrier" ::: "memory"); }
template <int CTRL> __device__ __forceinline__ float dppf(float v) { return __builtin_bit_cast(float, __builtin_amdgcn_update_dpp(0, __builtin_bit_cast(int, v), CTRL, 0xf, 0xf, true)); }
__device__ __forceinline__ void unpack8(const u32x4 w, float* f) {
    f[0] = bflo(w.x); f[1] = bfhi(w.x); f[2] = bflo(w.y); f[3] = bfhi(w.y); f[4] = bflo(w.z); f[5] = bfhi(w.z); f[6] = bflo(w.w); f[7] = bfhi(w.w);
}
__device__ __forceinline__ u32x4 pack8(const float* f) { u32x4 w; w.x = pkbf(f[0], f[1]); w.y = pkbf(f[2], f[3]); w.z = pkbf(f[4], f[5]); w.w = pkbf(f[6], f[7]); return w; }

struct EpiHgrnIn {
    static constexpr bool PERM = true, AFTER_DRAIN = false;
    bf16_t* base; const float* lb;
    __device__ __forceinline__ void operator()(const pg8::f32x4 (&acc)[2][2][4][2], const pg8::Unit& u, int wr, int wc, int fr, int fq) const {
        int opq = 0; asm volatile("" : "+v"(opq));
        const int type = u.pn >> 3;
        const int cb = (u.pn & 7) * 256 + wc * 32 + 8 * fq + opq;
        const int row0 = u.pm * 256 + wr * 64 + fr;
        if (type == 1 || type == 2) {
            bf16_t* dst = base + (size_t)type * (SZ / 2); const float* lbp = lb + (type - 1) * DM;
#pragma unroll
            for (int bj = 0; bj < 2; ++bj) { const int col = cb + bj * 128;
                const f32x4 l0 = *(const f32x4*)(lbp + col), l1 = *(const f32x4*)(lbp + col + 4);
#pragma unroll
                for (int ai = 0; ai < 2; ++ai)
#pragma unroll
                    for (int m = 0; m < 4; ++m) { const size_t row = row0 + ai * 128 + m * 16;
                        const f32x4 z0 = acc[ai][bj][m][0], z1 = acc[ai][bj][m][1]; float lf[8];
#pragma unroll
                        for (int e = 0; e < 4; ++e) { lf[e] = __log2f(l0[e] + (1.f - l0[e]) * fsigmoid(z0[e])); lf[4 + e] = __log2f(l1[e] + (1.f - l1[e]) * fsigmoid(z1[e])); }
                        u32x4 w; w.x = pk_f16(lf[0], lf[1]); w.y = pk_f16(lf[2], lf[3]); w.z = pk_f16(lf[4], lf[5]); w.w = pk_f16(lf[6], lf[7]);
                        *(u32x4*)(dst + row * DM + col) = w; } }
        } else {
            bf16_t* dst = base + (size_t)type * (SZ / 2);
#pragma unroll
            for (int bj = 0; bj < 2; ++bj) { const int col = cb + bj * 128;
#pragma unroll
                for (int ai = 0; ai < 2; ++ai)
#pragma unroll
                    for (int m = 0; m < 4; ++m) { const size_t row = row0 + ai * 128 + m * 16;
                        const f32x4 v0 = acc[ai][bj][m][0], v1 = acc[ai][bj][m][1];
                        u32x4 w; w.x = pkbf(v0[0], v0[1]); w.y = pkbf(v0[2], v0[3]); w.z = pkbf(v1[0], v1[1]); w.w = pkbf(v1[2], v1[3]);
                        *(u32x4*)(dst + row * DM + col) = w; } }
        }
    }
};
struct EpiResid {
    static constexpr bool PERM = true, AFTER_DRAIN = false;
    const float* x0; const float* x1; float* out; const float* gate;
    __device__ __forceinline__ void operator()(const pg8::f32x4 (&acc)[2][2][4][2], const pg8::Unit& u, int wr, int wc, int fr, int fq) const {
        int opq = 0; asm volatile("" : "+v"(opq));
        const int cb = u.pn * 256 + wc * 32 + 8 * fq + opq;
        const int row0 = u.pm * 256 + wr * 64 + fr;
        const float* gp = gate + (size_t)((u.pm * 256) >> 12) * NMOD;
        const float* src0 = (u.pm < 16) ? x0 : x1 - (size_t)NPR * DM;
#pragma unroll
        for (int bj = 0; bj < 2; ++bj) { const int col = cb + bj * 128;
            const f32x4 g0 = *(const f32x4*)(gp + col), g1 = *(const f32x4*)(gp + col + 4);
#pragma unroll
            for (int ai = 0; ai < 2; ++ai) { f32x4 xa[4], xb[4];
#pragma unroll
                for (int m = 0; m < 4; ++m) { const size_t off = (size_t)(row0 + ai * 128 + m * 16) * DM + col; xa[m] = *(const f32x4*)(src0 + off); xb[m] = *(const f32x4*)(src0 + off + 4); }
#pragma unroll
                for (int m = 0; m < 4; ++m) { const size_t off = (size_t)(row0 + ai * 128 + m * 16) * DM + col;
                    *(f32x4*)(out + off) = xa[m] + g0 * acc[ai][bj][m][0]; *(f32x4*)(out + off + 4) = xb[m] + g1 * acc[ai][bj][m][1]; }
                asm volatile("" ::: "memory"); } }
    }
};
struct EpiFfnUp {
    static constexpr bool PERM = true, AFTER_DRAIN = false;
    bf16_t* A; bf16_t* halo; const float* cw; const float* cbias;
    __device__ __forceinline__ void operator()(const pg8::f32x4 (&acc)[2][2][4][2], const pg8::Unit& u, int wr, int wc, int fr, int fq) const {
        int opq = 0; asm volatile("" : "+v"(opq));
        const int c0 = u.pn * 128 + wc * 32 + 8 * fq + opq;
        const int rowg = u.pm * 256 + wr * 64;
#pragma unroll
        for (int n = 0; n < 2; ++n) { const int cg = c0 + 4 * n, cv = DFF + cg;
            const f32x4 g0 = *(const f32x4*)(cw + cg), g1 = *(const f32x4*)(cw + NUP + cg), g2 = *(const f32x4*)(cw + 2 * NUP + cg), gb = *(const f32x4*)(cbias + cg);
            const f32x4 v0 = *(const f32x4*)(cw + cv), v1 = *(const f32x4*)(cw + NUP + cv), v2 = *(const f32x4*)(cw + 2 * NUP + cv), vb = *(const f32x4*)(cbias + cv);
#pragma unroll
            for (int ai = 0; ai < 2; ++ai)
#pragma unroll
                for (int m = 0; m < 4; ++m) {
                    const f32x4 ug = acc[ai][0][m][n], uv = acc[ai][1][m][n]; f32x4 pg, ng, pv, nv;
#pragma unroll
                    for (int e = 0; e < 4; ++e) {
                        pg[e] = dppf<0x111>(ug[e]); ng[e] = dppf<0x101>(ug[e]); pv[e] = dppf<0x111>(uv[e]); nv[e] = dppf<0x101>(uv[e]);
                        if (m > 0) { pg[e] += dppf<0x10F>(acc[ai][0][m > 0 ? m - 1 : 0][n][e]); pv[e] += dppf<0x10F>(acc[ai][1][m > 0 ? m - 1 : 0][n][e]); }
                        if (m < 3) { ng[e] += dppf<0x11F>(acc[ai][0][m < 3 ? m + 1 : 3][n][e]); nv[e] += dppf<0x11F>(acc[ai][1][m < 3 ? m + 1 : 3][n][e]); } }
                    const f32x4 cgv = g0 * pg + g1 * ug + g2 * ng + gb, cvv = v0 * pv + v1 * uv + v2 * nv + vb; f32x4 o;
#pragma unroll
                    for (int e = 0; e < 4; ++e) o[e] = cgv[e] * fsigmoid(cgv[e]) * cvv[e];
                    const int r = 16 * m + fr;
                    if (r != 0 && r != 63) { u32x2 w; w.x = pkbf(o[0], o[1]); w.y = pkbf(o[2], o[3]); *(u32x2*)(A + (size_t)(rowg + ai * 128 + r) * DFF + cg) = w; }
                    if (r <= 1 || r >= 62) { const int slot = r <= 1 ? r : r - 60; bf16_t* hp = halo + (size_t)(((rowg + ai * 128) >> 6) * 4 + slot) * NUP;
                        u32x2 wg, wv; wg.x = pkbf(ug[0], ug[1]); wg.y = pkbf(ug[2], ug[3]); wv.x = pkbf(uv[0], uv[1]); wv.y = pkbf(uv[2], uv[3]);
                        *(u32x2*)(hp + cg) = wg; *(u32x2*)(hp + cv) = wv; }
                } }
    }
};
struct EpiAttnIn {
    static constexpr bool PERM = true, AFTER_DRAIN = false;
    bf16_t *Q, *KA, *VA, *KP, *VP; float* nk; float* nv; const float* tab;
    __device__ __forceinline__ void operator()(const pg8::f32x4 (&acc)[2][2][4][2], const pg8::Unit& u, int wr, int wc, int fr, int fq) const {
        int opq = 0; asm volatile("" : "+v"(opq));
        const int type = u.pn >> 3;
        const int cb = (u.pn & 7) * 256 + wc * 32 + 8 * fq + opq;
        const int rl = wr * 64 + fr;
        const bool prompt = u.pm < 16;
        bf16_t* dst; float* fdst = nullptr; size_t drow0;
        if (type == 0) { dst = Q; drow0 = (size_t)u.pm * 256; }
        else if (prompt) { dst = type == 1 ? KP : VP; drow0 = (size_t)u.pm * 256; fdst = type == 1 ? nk : nv; }
        else { const int sb = (u.pm - 16) >> 4, t0 = ((u.pm - 16) & 15) * 256; dst = type == 1 ? KA : VA; drow0 = (size_t)sb * 4608 + t0; }
        if (type == 2) {
#pragma unroll
            for (int bj = 0; bj < 2; ++bj) { const int col = cb + bj * 128;
#pragma unroll
                for (int ai = 0; ai < 2; ++ai)
#pragma unroll
                    for (int m = 0; m < 4; ++m) { const size_t off = (drow0 + rl + ai * 128 + m * 16) * DM + col;
                        const f32x4 v0 = acc[ai][bj][m][0], v1 = acc[ai][bj][m][1];
                        u32x4 w; w.x = pkbf(v0[0], v0[1]); w.y = pkbf(v0[2], v0[3]); w.z = pkbf(v1[0], v1[1]); w.w = pkbf(v1[2], v1[3]);
                        *(u32x4*)(dst + off) = w;
                        if (fdst) { *(f32x4*)(fdst + off) = v0; *(f32x4*)(fdst + off + 4) = v1; } } }
        } else {
            const int ax = wc >> 1, f0 = 16 * (wc & 1) + 4 * fq;
            const int tb = prompt ? 0 : ((u.pm - 16) & 15) * 256 + wr * 64 + fr;
#pragma unroll
            for (int ai = 0; ai < 2; ++ai)
#pragma unroll
                for (int m = 0; m < 4; ++m) { const int t = tb + ai * 128 + m * 16, pos = ax ? (t & 63) : (t >> 6);
                    f32x4 c0 = {1.f, 0.f, 1.f, 0.f}, c1 = c0;
                    if (!prompt) { const float* tp = tab + (pos * 32 + f0) * 2; c0 = *(const f32x4*)tp; c1 = *(const f32x4*)(tp + 4); }
#pragma unroll
                    for (int bj = 0; bj < 2; ++bj) { const int col = cb + bj * 128; const size_t off = (drow0 + rl + ai * 128 + m * 16) * DM + col;
                        const f32x4 v0 = acc[ai][bj][m][0], v1 = acc[ai][bj][m][1]; f32x4 r0, r1;
                        r0[0] = v0[0] * c0[0] - v0[1] * c0[1]; r0[1] = v0[1] * c0[0] + v0[0] * c0[1]; r0[2] = v0[2] * c0[2] - v0[3] * c0[3]; r0[3] = v0[3] * c0[2] + v0[2] * c0[3];
                        r1[0] = v1[0] * c1[0] - v1[1] * c1[1]; r1[1] = v1[1] * c1[0] + v1[0] * c1[1]; r1[2] = v1[2] * c1[2] - v1[3] * c1[3]; r1[3] = v1[3] * c1[2] + v1[2] * c1[3];
                        u32x4 w; w.x = pkbf(r0[0], r0[1]); w.y = pkbf(r0[2], r0[3]); w.z = pkbf(r1[0], r1[1]); w.w = pkbf(r1[2], r1[3]);
                        *(u32x4*)(dst + off) = w;
                        if (fdst) { const size_t lo = (drow0 + rl + ai * 128 + m * 16) * DM + (u.pn & 7) * 256 + bj * 128 + ax * 64 + f0 + opq;
                            *(f32x4*)(fdst + lo) = (f32x4){v0[0], v0[2], v1[0], v1[2]}; *(f32x4*)(fdst + lo + 32) = (f32x4){v0[1], v0[3], v1[1], v1[3]}; } } }
        }
    }
};

__device__ __forceinline__ void transpose_item(const float* W, int K, int N, bf16_t* WT, int mode, LAS float* scr, int item, int lane) {
    const int nblk = N / 32, kb = item / nblk, nb = item % nblk, k0 = 64 * kb, n0 = 32 * nb;
    int d0 = n0, dstr = 1;
    if (mode == 1) d0 = n0 < DFF ? (n0 >> 7) * 256 + (n0 & 127) : ((n0 - DFF) >> 7) * 256 + 128 + ((n0 - DFF) & 127);
    if (mode == 2 && n0 < 2 * DM) { d0 = (n0 & ~127) + (n0 & 64) + ((n0 >> 5) & 1); dstr = 2; }
#pragma unroll 16
    for (int i = 0; i < 32; ++i) { const int kk = 2 * i + (lane >> 5); scr[kk * 33 + (lane & 31)] = W[(size_t)(k0 + kk) * N + n0 + (lane & 31)]; }
    asm volatile("s_waitcnt lgkmcnt(0)" ::: "memory");
    const int c = lane & 7;
#pragma unroll
    for (int j = 0; j < 4; ++j) { const int n = (lane >> 3) + 8 * j; const LAS float* s = scr + (8 * c) * 33 + n;
        u32x4 o; o.x = pkbf(s[0 * 33], s[1 * 33]); o.y = pkbf(s[2 * 33], s[3 * 33]); o.z = pkbf(s[4 * 33], s[5 * 33]); o.w = pkbf(s[6 * 33], s[7 * 33]);
        *(u32x4*)(WT + (size_t)(d0 + n * dstr) * K + k0 + 8 * c) = o; }
    asm volatile("s_waitcnt lgkmcnt(0)" ::: "memory");
}
__device__ __forceinline__ const float* KIN(int k);
__device__ __forceinline__ void transpose_layer(int l, unsigned char* ws, LAS unsigned char* lds, int tw, int ntw, int wave, int lane) {
    LAS float* scr = (LAS float*)(lds + wave * 16384);
    const float* Win = KIN(l == 0 ? 11 : 15); const int Nin = l == 0 ? 10240 : 6144;
    const float* Wout = KIN(l == 0 ? 14 : 18);
    const float* Wup = KIN(19) + (size_t)l * DM * NUP; const float* Wdn = KIN(22) + (size_t)l * DFF * DM;
    const int I_in = 32 * (Nin / 32), I_out = 32 * 64, I_up = 32 * (NUP / 32), I_dn = (DFF / 64) * 64;
    const int total = I_in + I_out + I_up + I_dn;
    for (int it = tw; it < total; it += ntw) { int r = it;
        if (r < I_up) { transpose_item(Wup, DM, NUP, (bf16_t*)(ws + WS_WUP), 1, scr, r, lane); continue; } r -= I_up;
        if (r < I_in) { transpose_item(Win, DM, Nin, (bf16_t*)(ws + WS_WIN), l == 1 ? 2 : 0, scr, r, lane); continue; } r -= I_in;
        if (r < I_dn) { transpose_item(Wdn, DFF, DM, (bf16_t*)(ws + WS_WDOWN), 0, scr, r, lane); continue; } r -= I_dn;
        transpose_item(Wout, DM, DM, (bf16_t*)(ws + WS_WOUT), 0, scr, r, lane); }
}
__device__ __forceinline__ void mod_task(int task, const float* cvec, const float* cctx, const float* wmod, const float* bmod, float* mod, LAS unsigned char* lds, int tid, int wave, int lane) {
    LAS float* sil = (LAS float*)lds;
    LAS float* red = (LAS float*)(lds + 12288);
    const int kq = task & 7, cl = task >> 3, l = cl / 48, cgp = cl % 48, kbase = kq * 256;
    for (int i = tid; i < 9 * 256; i += 512) { const int n = i >> 8, k = i & 255; const float c = n == 0 ? cctx[kbase + k] : cvec[(n - 1) * DM + kbase + k]; sil[k * 12 + n] = c / (1.f + expf(-c)); }
    __syncthreads();
    const float* W = wmod + (size_t)l * DM * NMOD + (size_t)kbase * NMOD + cgp * 256 + lane * 4;
    float acc[9][4];
#pragma unroll
    for (int n = 0; n < 9; ++n)
#pragma unroll
        for (int e = 0; e < 4; ++e) acc[n][e] = 0.f;
#pragma unroll 8
    for (int kk = 0; kk < 32; ++kk) { const int k = wave * 32 + kk;
        const f32x4 w = *(const f32x4*)(W + (size_t)k * NMOD);
        const f32x4 s0 = *(const LAS f32x4*)(sil + k * 12), s1 = *(const LAS f32x4*)(sil + k * 12 + 4); const float s8 = sil[k * 12 + 8];
#pragma unroll
        for (int e = 0; e < 4; ++e) { acc[0][e] += s0[0] * w[e]; acc[1][e] += s0[1] * w[e]; acc[2][e] += s0[2] * w[e]; acc[3][e] += s0[3] * w[e];
            acc[4][e] += s1[0] * w[e]; acc[5][e] += s1[1] * w[e]; acc[6][e] += s1[2] * w[e]; acc[7][e] += s1[3] * w[e]; acc[8][e] += s8 * w[e]; } }
#pragma unroll
    for (int s = 4; s >= 1; s >>= 1) {
        if (wave >= s && wave < 2 * s) {
#pragma unroll
            for (int n = 0; n < 9; ++n)
#pragma unroll
                for (int e = 0; e < 4; ++e) red[((wave - s) * 36 + n * 4 + e) * 64 + lane] = acc[n][e]; }
        __syncthreads();
        if (wave < s) {
#pragma unroll
            for (int n = 0; n < 9; ++n)
#pragma unroll
                for (int e = 0; e < 4; ++e) acc[n][e] += red[(wave * 36 + n * 4 + e) * 64 + lane]; }
        __syncthreads();
    }
    if (wave == 0) { const int col = cgp * 256 + lane * 4; f32x4 b = {0.f, 0.f, 0.f, 0.f}; if (kq == 0) b = *(const f32x4*)(bmod + (size_t)l * NMOD + col);
#pragma unroll
        for (int n = 0; n < 9; ++n) { float* dst = mod + ((size_t)l * 9 + n) * NMOD + col;
#pragma unroll
            for (int e = 0; e < 4; ++e) __builtin_amdgcn_global_atomic_fadd_f32((__attribute__((address_space(1))) float*)(dst + e), acc[n][e] + b[e]); } }
    __syncthreads();
}
__device__ __forceinline__ void norm_pass(const float* x0, const float* x1, const float* g, const float* modl, int shk, int sck, bf16_t* H, int gw, int ngw, int lane) {
    for (int rowa = gw; rowa < MTOT; rowa += 2 * ngw) { const int rowb = rowa + ngw < MTOT ? rowa + ngw : rowa;
        const float* xa = rowa < NPR ? x0 + (size_t)rowa * DM : x1 + (size_t)(rowa - NPR) * DM;
        const float* xb = rowb < NPR ? x0 + (size_t)rowb * DM : x1 + (size_t)(rowb - NPR) * DM;
        f32x4 va[8], vb[8]; float sa = 0.f, sb = 0.f;
#pragma unroll
        for (int j = 0; j < 8; ++j) { va[j] = *(const f32x4*)(xa + 4 * (lane + 64 * j)); vb[j] = *(const f32x4*)(xb + 4 * (lane + 64 * j)); }
#pragma unroll
        for (int j = 0; j < 8; ++j) { sa += va[j][0] * va[j][0] + va[j][1] * va[j][1] + va[j][2] * va[j][2] + va[j][3] * va[j][3]; sb += vb[j][0] * vb[j][0] + vb[j][1] * vb[j][1] + vb[j][2] * vb[j][2] + vb[j][3] * vb[j][3]; }
#pragma unroll
        for (int o = 1; o < 64; o <<= 1) { sa += shx(sa, o, lane); sb += shx(sb, o, lane); }
        const float ra = rsqrtf(sa * (1.f / DM) + EPS), rb = rsqrtf(sb * (1.f / DM) + EPS);
        const float* ma = modl + (size_t)(rowa >> 12) * NMOD; const float* mb = modl + (size_t)(rowb >> 12) * NMOD;
#pragma unroll
        for (int j = 0; j < 8; ++j) { const int c = 4 * (lane + 64 * j); const f32x4 gg = *(const f32x4*)(g + c);
            const f32x4 sca = *(const f32x4*)(ma + sck * DM + c), sha = *(const f32x4*)(ma + shk * DM + c), scb = *(const f32x4*)(mb + sck * DM + c), shb = *(const f32x4*)(mb + shk * DM + c);
            const f32x4 oa = (va[j] * ra * gg) * (sca + 1.f) + sha, ob = (vb[j] * rb * gg) * (scb + 1.f) + shb;
            u32x2 wa, wb; wa.x = pkbf(oa[0], oa[1]); wa.y = pkbf(oa[2], oa[3]); wb.x = pkbf(ob[0], ob[1]); wb.y = pkbf(ob[2], ob[3]);
            *(u32x2*)(H + (size_t)rowa * DM + c) = wa; *(u32x2*)(H + (size_t)rowb * DM + c) = wb; }
    }
}
__device__ __forceinline__ void final_norm(float* x, const float* g, int gw, int ngw, int lane, float* dst = nullptr) {
    for (int rowa = gw; rowa < MTOT; rowa += 2 * ngw) { const int rowb = rowa + ngw < MTOT ? rowa + ngw : rowa;
        float* xa = x + (size_t)rowa * DM; float* xb = x + (size_t)rowb * DM; float* da = dst ? dst + (size_t)rowa * DM : xa; float* db = dst ? dst + (size_t)rowb * DM : xb;
        f32x4 va[8], vb[8]; float sa = 0.f, sb = 0.f;
#pragma unroll
        for (int j = 0; j < 8; ++j) { va[j] = *(const f32x4*)(xa + 4 * (lane + 64 * j)); vb[j] = *(const f32x4*)(xb + 4 * (lane + 64 * j)); }
#pragma unroll
        for (int j = 0; j < 8; ++j) { sa += va[j][0] * va[j][0] + va[j][1] * va[j][1] + va[j][2] * va[j][2] + va[j][3] * va[j][3]; sb += vb[j][0] * vb[j][0] + vb[j][1] * vb[j][1] + vb[j][2] * vb[j][2] + vb[j][3] * vb[j][3]; }
#pragma unroll
        for (int o = 1; o < 64; o <<= 1) { sa += shx(sa, o, lane); sb += shx(sb, o, lane); }
        const float ra = rsqrtf(sa * (1.f / DM) + EPS), rb = rsqrtf(sb * (1.f / DM) + EPS);
#pragma unroll
        for (int j = 0; j < 8; ++j) { const int c = 4 * (lane + 64 * j); const f32x4 gg = *(const f32x4*)(g + c);
            *(f32x4*)(da + c) = va[j] * ra * gg; if (rowb != rowa) *(f32x4*)(db + c) = vb[j] * rb * gg; }
    }
}
__device__ __forceinline__ void hgrn_combine(const bf16_t* Of, const bf16_t* Ob, const bf16_t* G, const float* onorm, bf16_t* Y, int gw, int ngw, int lane) {
    const int ch = (lane & 15) * 8; const f32x4 w0 = *(const f32x4*)(onorm + ch), w1 = *(const f32x4*)(onorm + ch + 4);
    for (int row = gw; row < MTOT; row += ngw) { u32x4 ra[4], rb[4], rg[4];
#pragma unroll
        for (int j = 0; j < 4; ++j) { const size_t off = (size_t)row * DM + j * 512 + lane * 8; ra[j] = *(const u32x4*)(Of + off); rb[j] = *(const u32x4*)(Ob + off); rg[j] = *(const u32x4*)(G + off); }
#pragma unroll
        for (int j = 0; j < 4; ++j) { const size_t off = (size_t)row * DM + j * 512 + lane * 8;
            float a[8], b[8], gg[8]; unpack8(ra[j], a); unpack8(rb[j], b); unpack8(rg[j], gg);
            float ss = 0.f;
#pragma unroll
            for (int e = 0; e < 8; ++e) { a[e] += b[e]; ss += a[e] * a[e]; }
            ss += shx(ss, 1, lane); ss += shx(ss, 2, lane); ss += shx(ss, 4, lane); ss += shx(ss, 8, lane);
            const float rstd = rsqrtf(ss * (1.f / 128.f) + EPS);
#pragma unroll
            for (int e = 0; e < 8; ++e) a[e] = a[e] * rstd * (e < 4 ? w0[e] : w1[e - 4]) * (gg[e] * fsigmoid(gg[e]));
            *(u32x4*)(Y + off) = pack8(a); }
    }
}
__device__ __forceinline__ void attn_combine(const bf16_t* O4, const float* lamp, const float* subln, bf16_t* Y, int gw, int ngw, int lane) {
    const float lam_init = 0.8f - 0.6f * expf(-0.3f);
    const float p1 = wave_sum(lamp[lane] * lamp[128 + lane] + lamp[64 + lane] * lamp[192 + lane], lane);
    const float p2 = wave_sum(lamp[256 + lane] * lamp[384 + lane] + lamp[320 + lane] * lamp[448 + lane], lane);
    const float lam = expf(p1) - expf(p2) + lam_init;
    const int e0 = (lane & 31) * 8; const f32x4 w0 = *(const f32x4*)(subln + e0), w1 = *(const f32x4*)(subln + e0 + 4);
    for (int row = gw; row < MTOT; row += ngw) { u32x4 ra[4], rb[4];
#pragma unroll
        for (int j = 0; j < 4; ++j) { const int head = 2 * j + (lane >> 5); const size_t off = (size_t)row * 4096 + head * 512 + e0; ra[j] = *(const u32x4*)(O4 + off); rb[j] = *(const u32x4*)(O4 + off + 256); }
#pragma unroll
        for (int j = 0; j < 4; ++j) { const int head = 2 * j + (lane >> 5);
            float a[8], b[8]; unpack8(ra[j], a); unpack8(rb[j], b);
            float ss = 0.f;
#pragma unroll
            for (int e = 0; e < 8; ++e) { a[e] -= lam * b[e]; ss += a[e] * a[e]; }
            ss += shx(ss, 1, lane); ss += shx(ss, 2, lane); ss += shx(ss, 4, lane); ss += shx(ss, 8, lane); ss += shx(ss, 16, lane);
            const float rstd = rsqrtf(ss * (1.f / 256.f) + EPS) * (1.f - lam_init);
#pragma unroll
            for (int e = 0; e < 8; ++e) a[e] = a[e] * rstd * (e < 4 ? w0[e] : w1[e - 4]);
            *(u32x4*)(Y + (size_t)row * DM + head * 256 + e0) = pack8(a); }
    }
}
__device__ __forceinline__ void rope_pass(bf16_t* Q, bf16_t* KA, const float* tab, int gw, int ngw, int lane, long dsto = 0) {
    for (int task = gw; task < 65536; task += ngw) { const int arr = task >> 15, st = task & 32767, b = st >> 12, t = st & 4095;
        bf16_t* rowp = arr == 0 ? Q + (size_t)(NPR + st) * DM : KA + (size_t)(b * 4608 + t) * DM;
        u32x4 r1[2], r2[2];
#pragma unroll
        for (int i = 0; i < 2; ++i) { const int T = lane + 64 * i, head = T >> 3, ax = (T >> 2) & 1, f0 = (T & 3) * 8; const bf16_t* p1 = rowp + head * 128 + ax * 64 + f0; r1[i] = *(const u32x4*)p1; r2[i] = *(const u32x4*)(p1 + 32); }
#pragma unroll
        for (int i = 0; i < 2; ++i) { const int T = lane + 64 * i, head = T >> 3, ax = (T >> 2) & 1, f0 = (T & 3) * 8, pos = ax ? (t & 63) : (t >> 6);
            bf16_t* p1 = rowp + head * 128 + ax * 64 + f0; float x1[8], x2[8]; unpack8(r1[i], x1); unpack8(r2[i], x2);
            const float* tp = tab + (pos * 32 + f0) * 2; float o1[8], o2[8];
#pragma unroll
            for (int q = 0; q < 4; ++q) { const f32x4 cs = *(const f32x4*)(tp + 4 * q);
                o1[2 * q] = x1[2 * q] * cs[0] - x2[2 * q] * cs[1]; o2[2 * q] = x2[2 * q] * cs[0] + x1[2 * q] * cs[1];
                o1[2 * q + 1] = x1[2 * q + 1] * cs[2] - x2[2 * q + 1] * cs[3]; o2[2 * q + 1] = x2[2 * q + 1] * cs[2] + x1[2 * q + 1] * cs[3]; }
            *(u32x4*)(p1 + dsto) = pack8(o1); *(u32x4*)(p1 + 32 + dsto) = pack8(o2); }
    }
}
__device__ __forceinline__ void cache_convert(const float* ck, const float* cv, bf16_t* KA, bf16_t* VA, int gw, int ngw, int lane) {
    for (int task = gw; task < 4096 * 4; task += ngw) { const int r = task >> 2, part = task & 3, b = r >> 9, p = r & 511;
        const float* src = cv + (size_t)r * DM + part * 512 + lane * 8; bf16_t* dst = VA + (size_t)(b * 4608 + 4096 + p) * DM + part * 512 + lane * 8;
        const f32x4 a = *(const f32x4*)src, c = *(const f32x4*)(src + 4);
        u32x4 w; w.x = pkbf(a[0], a[1]); w.y = pkbf(a[2], a[3]); w.z = pkbf(c[0], c[1]); w.w = pkbf(c[2], c[3]); *(u32x4*)dst = w; }
    for (int r = gw; r < 4096; r += ngw) { const int b = r >> 9, p = r & 511;
        const float* srow = ck + (size_t)r * DM; bf16_t* drow = KA + (size_t)(b * 4608 + 4096 + p) * DM;
#pragma unroll
        for (int i = 0; i < 2; ++i) { const int T = lane + 64 * i, head = T >> 3, ax = (T >> 2) & 1, f0 = (T & 3) * 8;
            const float* s1 = srow + head * 128 + ax * 64 + f0;
            const f32x4 a0 = *(const f32x4*)s1, a1 = *(const f32x4*)(s1 + 4), b0 = *(const f32x4*)(s1 + 32), b1 = *(const f32x4*)(s1 + 36);
            u32x4 w0, w1; w0.x = pkbf(a0[0], b0[0]); w0.y = pkbf(a0[1], b0[1]); w0.z = pkbf(a0[2], b0[2]); w0.w = pkbf(a0[3], b0[3]);
            w1.x = pkbf(a1[0], b1[0]); w1.y = pkbf(a1[1], b1[1]); w1.z = pkbf(a1[2], b1[2]); w1.w = pkbf(a1[3], b1[3]);
            bf16_t* d = drow + head * 128 + ax * 64 + 2 * f0; *(u32x4*)d = w0; *(u32x4*)(d + 8) = w1; } }
}
__device__ __forceinline__ void ffn_fixup(const bf16_t* halo, const float* cw, const float* cbias, bf16_t* A, int gw, int ngw, int lane) {
    for (int task = gw; task < (MTOT / 64) * 2; task += ngw) { const int grp = task >> 1, last = task & 1, row = grp * 64 + (last ? 63 : 0);
        const int seq0 = row < NPR ? (row & ~255) : NPR + ((row - NPR) & ~4095), seqL = row < NPR ? 256 : 4096;
        const bool hasp = row > seq0, hasn = row < seq0 + seqL - 1;
        const bf16_t* hc = halo + (size_t)(grp * 4 + (last ? 3 : 0)) * NUP;
        const bf16_t* hp = last ? halo + (size_t)(grp * 4 + 2) * NUP : halo + (size_t)((grp - 1) * 4 + 3) * NUP;
        const bf16_t* hn = last ? halo + (size_t)((grp + 1) * 4 + 0) * NUP : halo + (size_t)(grp * 4 + 1) * NUP;
        for (int j = 0; j < 11; ++j) { const int cg = j * 512 + lane * 8, cv = DFF + cg;
            float ug[8], uv[8], pg[8], pv[8], ng[8], nv[8]; unpack8(*(const u32x4*)(hc + cg), ug); unpack8(*(const u32x4*)(hc + cv), uv);
#pragma unroll
            for (int e = 0; e < 8; ++e) { pg[e] = 0.f; pv[e] = 0.f; ng[e] = 0.f; nv[e] = 0.f; }
            if (hasp) { unpack8(*(const u32x4*)(hp + cg), pg); unpack8(*(const u32x4*)(hp + cv), pv); }
            if (hasn) { unpack8(*(const u32x4*)(hn + cg), ng); unpack8(*(const u32x4*)(hn + cv), nv); }
            float o[8];
#pragma unroll
            for (int e = 0; e < 8; ++e) { const float gv = cw[cg + e] * pg[e] + cw[NUP + cg + e] * ug[e] + cw[2 * NUP + cg + e] * ng[e] + cbias[cg + e];
                const float vv = cw[cv + e] * pv[e] + cw[NUP + cv + e] * uv[e] + cw[2 * NUP + cv + e] * nv[e] + cbias[cv + e]; o[e] = gv * fsigmoid(gv) * vv; }
            *(u32x4*)(A + (size_t)row * DFF + cg) = pack8(o); }
    }
}

constexpr int SC_LF = 0, SC_SEG = 33792, SC_QT = 35840, SC_KT = 53248, SC_VS = 70656, SC_PL = 107520, SC_ER = 116736;
typedef short v4i16_t __attribute__((ext_vector_type(4)));
__device__ __forceinline__ bf16x8 tr_pair(const LAS unsigned char* p) {
    const v4i16_t a = __builtin_amdgcn_ds_read_tr16_b64_v4i16((LAS v4i16_t*)p), b = __builtin_amdgcn_ds_read_tr16_b64_v4i16((LAS v4i16_t*)(p + 4 * 272));
    return (bf16x8){a[0], a[1], a[2], a[3], b[0], b[1], b[2], b[3]}; }
__device__ __forceinline__ void hgrn_unit(LAS unsigned char* lds, const bf16_t* Qh, const bf16_t* Vh, const bf16_t* LF, bf16_t* Od, const float* S0, float* Sout,
                                          int seqbase, int nch, int h, int dir, int tid, int wave, int lane) {
    int opq = 0; asm volatile("" : "+v"(opq));
    const int g = (lane >> 4) + opq, l16 = lane & 15;
    const int fs = (tid >> 4) + opq, fc = (tid & 15) * 8;
    LAS float* LFs = (LAS float*)(lds + SC_LF); LAS float* SEG = (LAS float*)(lds + SC_SEG);
    LAS float* ER = (LAS float*)(lds + SC_ER); LAS float* EL = ER + 128; LAS float* ELR = ER + 256;
    LAS bf16_t* PL = (LAS bf16_t*)(lds + SC_PL);
    const int trq = (lane & 15) >> 2, trp = lane & 3;
    f32x4 Sacc[8];
#pragma unroll
    for (int mt = 0; mt < 8; ++mt)
#pragma unroll
        for (int i = 0; i < 4; ++i) Sacc[mt][i] = S0 ? S0[(16 * mt + 4 * g + i) * 128 + 16 * wave + l16] : 0.f;
    for (int i = tid; i < 64 * 72 / 2; i += 512) ((LAS unsigned*)(lds + SC_PL))[i] = 0u;
    u32x4 pq[2], pv[2], pl[2];
    { const int c0 = dir ? nch - 1 : 0;
#pragma unroll
      for (int i = 0; i < 2; ++i) { const size_t off = (size_t)(seqbase + 64 * c0 + fs + 32 * i) * DM + h * 128 + fc;
          pq[i] = *(const u32x4*)(Qh + off); pv[i] = *(const u32x4*)(Vh + off); pl[i] = *(const u32x4*)(LF + off); } }
    for (int step = 0; step < nch; ++step) {
        const int cidx = dir ? nch - 1 - step : step; const int R0 = seqbase + 64 * cidx;
        u32x4 cq[2], cv[2], cl[2];
#pragma unroll
        for (int i = 0; i < 2; ++i) { cq[i] = pq[i]; cv[i] = pv[i]; cl[i] = pl[i]; }
#pragma unroll
        for (int i = 0; i < 2; ++i) { LAS float* d = LFs + (fs + 32 * i) * 132 + fc;
            f32x4 a, b; a[0] = f16lo(cl[i].x); a[1] = f16hi(cl[i].x); a[2] = f16lo(cl[i].y); a[3] = f16hi(cl[i].y); b[0] = f16lo(cl[i].z); b[1] = f16hi(cl[i].z); b[2] = f16lo(cl[i].w); b[3] = f16hi(cl[i].w);
            *(LAS f32x4*)d = a; *(LAS f32x4*)(d + 4) = b; }
        if (step + 1 < nch) { const int cn = dir ? cidx - 1 : cidx + 1;
#pragma unroll
            for (int i = 0; i < 2; ++i) { const size_t off = (size_t)(seqbase + 64 * cn + fs + 32 * i) * DM + h * 128 + fc;
                pq[i] = *(const u32x4*)(Qh + off); pv[i] = *(const u32x4*)(Vh + off); pl[i] = *(const u32x4*)(LF + off); } }
        lds_barrier();
        { const int c = tid & 127, seg = tid >> 7; float v[16];
#pragma unroll
          for (int r = 0; r < 16; ++r) v[r] = LFs[(16 * seg + (dir ? 15 - r : r)) * 132 + c];
#pragma unroll
          for (int r = 1; r < 16; ++r) v[r] += v[r - 1];
#pragma unroll
          for (int r = 0; r < 16; ++r) LFs[(16 * seg + (dir ? 15 - r : r)) * 132 + c] = v[r];
          SEG[seg * 128 + c] = v[15]; }
        lds_barrier();
        { const bool hiseg = (fs >> 4) != 0; const int mr = dir ? 32 : 31, lr = dir ? 0 : 63;
#pragma unroll
          for (int hf = 0; hf < 2; ++hf) { const int c4 = fc + 4 * hf;
              const f32x4 T0 = *(const LAS f32x4*)(SEG + c4), T1 = *(const LAS f32x4*)(SEG + 128 + c4), T2 = *(const LAS f32x4*)(SEG + 256 + c4), T3 = *(const LAS f32x4*)(SEG + 384 + c4);
              const f32x4 z4 = {0.f, 0.f, 0.f, 0.f}; f32x4 om, ol, o0, o1;
              if (!dir) { om = T0; ol = T0 + T1 + T2; o0 = hiseg ? T0 : z4; o1 = T0 + T1 + (hiseg ? T2 : z4); }
              else { om = T3; ol = T3 + T2 + T1; o1 = hiseg ? z4 : T3; o0 = T3 + T2 + (hiseg ? z4 : T1); }
              const f32x4 rr = *(const LAS f32x4*)(LFs + mr * 132 + c4) + om;
              if (fs == 0) { const f32x4 bl = *(const LAS f32x4*)(LFs + lr * 132 + c4) + ol;
#pragma unroll
                  for (int e = 0; e < 4; ++e) { ER[c4 + e] = __builtin_amdgcn_exp2f(rr[e]); EL[c4 + e] = __builtin_amdgcn_exp2f(bl[e]); ELR[c4 + e] = __builtin_amdgcn_exp2f(bl[e] - rr[e]); } }
#pragma unroll
              for (int i = 0; i < 2; ++i) { const int s = fs + 32 * i;
                  const f32x4 bb = *(const LAS f32x4*)(LFs + s * 132 + c4) + (i ? o1 : o0);
                  const unsigned qw0 = hf ? cq[i].z : cq[i].x, qw1 = hf ? cq[i].w : cq[i].y, vw0 = hf ? cv[i].z : cv[i].x, vw1 = hf ? cv[i].w : cv[i].y, lw0 = hf ? cl[i].z : cl[i].x, lw1 = hf ? cl[i].w : cl[i].y;
                  const float q[4] = {bflo(qw0), bfhi(qw0), bflo(qw1), bfhi(qw1)}; const float lf[4] = {f16lo(lw0), f16hi(lw0), f16lo(lw1), f16hi(lw1)};
                  float qt[4], kt[4];
#pragma unroll
                  for (int e = 0; e < 4; ++e) { float d = bb[e] - rr[e]; d = fminf(fmaxf(d, -115.f), 115.f); qt[e] = q[e] * __builtin_amdgcn_exp2f(d); kt[e] = (1.f - __builtin_amdgcn_exp2f(lf[e])) * __builtin_amdgcn_exp2f(-d); }
                  u32x2 qw, kw; qw.x = pkbf(qt[0], qt[1]); qw.y = pkbf(qt[2], qt[3]); kw.x = pkbf(kt[0], kt[1]); kw.y = pkbf(kt[2], kt[3]);
                  *(LAS u32x2*)(lds + SC_QT + s * 272 + c4 * 2) = qw; *(LAS u32x2*)(lds + SC_KT + s * 272 + c4 * 2) = kw;
                  u32x2 vw; vw.x = vw0; vw.y = vw1; *(LAS u32x2*)(lds + SC_VS + s * 272 + c4 * 2) = vw; }
              asm volatile("" ::: "memory"); }
        }
        lds_barrier();
        for (int ti_ = wave; ti_ < 10; ti_ += 8) {
            int ti, sj; { int a = ti_ < 1 ? 0 : ti_ < 3 ? 1 : ti_ < 6 ? 2 : 3; int b = ti_ - (a * (a + 1)) / 2; if (!dir) { ti = a; sj = b; } else { ti = 3 - a; sj = 3 - b; } }
            f32x4 p = {0.f, 0.f, 0.f, 0.f};
#pragma unroll
            for (int kk = 0; kk < 4; ++kk) { const bf16x8 xa = *(const LAS bf16x8*)(lds + SC_QT + (16 * ti + l16) * 272 + 64 * kk + 16 * g);
                const bf16x8 yb = *(const LAS bf16x8*)(lds + SC_KT + (16 * sj + l16) * 272 + 64 * kk + 16 * g);
                p = __builtin_amdgcn_mfma_f32_16x16x32_bf16(xa, yb, p, 0, 0, 0); }
#pragma unroll
            for (int i = 0; i < 4; ++i) { const int t = 16 * ti + 4 * g + i, s = 16 * sj + l16; const bool keep = dir ? (s >= t) : (s <= t);
                PL[t * 72 + s] = (bf16_t)(pkbf(keep ? p[i] : 0.f, 0.f) & 0xffffu); }
        }
        asm volatile("" ::: "memory");
        f32x4 oacc[4];
#pragma unroll
        for (int ti = 0; ti < 4; ++ti) oacc[ti] = (f32x4){0.f, 0.f, 0.f, 0.f};
#pragma unroll
        for (int kk = 0; kk < 4; ++kk) {
            const f32x4 e0 = *(const LAS f32x4*)(ER + 32 * kk + 4 * g), e1 = *(const LAS f32x4*)(ER + 32 * kk + 16 + 4 * g);
            const f32x4 s0 = Sacc[2 * kk] * e0, s1 = Sacc[2 * kk + 1] * e1;
            u32x4 yw; yw.x = pkbf(s0[0], s0[1]); yw.y = pkbf(s0[2], s0[3]); yw.z = pkbf(s1[0], s1[1]); yw.w = pkbf(s1[2], s1[3]);
            const bf16x8 yb = __builtin_bit_cast(bf16x8, yw);
#pragma unroll
            for (int ti = 0; ti < 4; ++ti) { const LAS unsigned char* qp = lds + SC_QT + (16 * ti + l16) * 272 + 64 * kk + 8 * g;
                const u32x2 a0 = *(const LAS u32x2*)qp, a1 = *(const LAS u32x2*)(qp + 32);
                u32x4 xw; xw.x = a0.x; xw.y = a0.y; xw.z = a1.x; xw.w = a1.y;
                oacc[ti] = __builtin_amdgcn_mfma_f32_16x16x32_bf16(__builtin_bit_cast(bf16x8, xw), yb, oacc[ti], 0, 0, 0); }
        }
        bf16x8 vb[2];
#pragma unroll
        for (int ks = 0; ks < 2; ++ks) vb[ks] = tr_pair(lds + SC_VS + (32 * ks + 8 * g + trq) * 272 + (16 * wave + 4 * trp) * 2);
#pragma unroll
        for (int mt = 0; mt < 8; ++mt) { f32x4 d = {0.f, 0.f, 0.f, 0.f};
#pragma unroll
            for (int ks = 0; ks < 2; ++ks) { const bf16x8 xa = tr_pair(lds + SC_KT + (32 * ks + 8 * g + trq) * 272 + (16 * mt + 4 * trp) * 2);
                d = __builtin_amdgcn_mfma_f32_16x16x32_bf16(xa, vb[ks], d, 0, 0, 0); }
            const f32x4 el = *(const LAS f32x4*)(EL + 16 * mt + 4 * g), elr = *(const LAS f32x4*)(ELR + 16 * mt + 4 * g);
            Sacc[mt] = el * Sacc[mt] + elr * d; if (mt == 3) asm volatile("" ::: "memory"); }
        lds_barrier();
#pragma unroll
        for (int ti = 0; ti < 4; ++ti)
#pragma unroll
            for (int ks = 0; ks < 2; ++ks) { const bf16x8 xa = *(const LAS bf16x8*)(lds + SC_PL + (16 * ti + l16) * 144 + 64 * ks + 16 * g);
                oacc[ti] = __builtin_amdgcn_mfma_f32_16x16x32_bf16(xa, vb[ks], oacc[ti], 0, 0, 0); }
#pragma unroll
        for (int ti = 0; ti < 4; ++ti)
#pragma unroll
            for (int i = 0; i < 4; ++i) Od[(size_t)(R0 + 16 * ti + 4 * g + i) * DM + h * 128 + 16 * wave + l16] = (bf16_t)(pkbf(oacc[ti][i], 0.f) & 0xffffu);
    }
    if (Sout) { int opq2 = 0; asm volatile("" : "+v"(opq2)); Sout += opq2;
#pragma unroll
        for (int mt = 0; mt < 8; ++mt)
#pragma unroll
            for (int i = 0; i < 4; ++i) Sout[(16 * mt + 4 * g + i) * 128 + 16 * wave + l16] = Sacc[mt][i]; }
    __syncthreads();
}


#define XB_TMO      128
#define XB_XCNT(j)  (256  + 64 * (j))
#define XB_XSUB(j)  (1280 + 64 * (j))
#define XB_XGEN(j)  (2304 + 64 * (j))
#define XB_TOP      3328
#define XB_TOPGEN   3392
#define XCD_BAR_WORDS 3456
#define XB_SPIN_CAP (1u << 18)

__device__ __forceinline__ unsigned xb_ld(unsigned* p)              { return __hip_atomic_load(p, __ATOMIC_RELAXED, __HIP_MEMORY_SCOPE_AGENT); }
__device__ __forceinline__ unsigned xb_add(unsigned* p, unsigned v) { return __hip_atomic_fetch_add(p, v, __ATOMIC_RELAXED, __HIP_MEMORY_SCOPE_AGENT); }
__device__ __forceinline__ unsigned xb_xcc_id() { return (unsigned)__builtin_amdgcn_s_getreg((3 << 11) | 20) & 0xFu; }
#define XB_SPIN(cond, bar) do { unsigned _sp = 0; while (cond) { __builtin_amdgcn_s_sleep(1); \
    if ((++_sp & 255u) == 0u) { if (xb_ld(&(bar)[XB_TMO])) break; if (_sp > XB_SPIN_CAP) { atomicAdd(&(bar)[XB_TMO], 1u); break; } } } } while (0)

struct XcdBarrier {
    unsigned* bar; unsigned x;
    volatile LAS unsigned* st;
};

__device__ __forceinline__ XcdBarrier xcd_barrier_post(unsigned* bar, volatile LAS unsigned* st) {
    XcdBarrier b; b.bar = bar; b.x = xb_xcc_id(); b.st = st;
    if (threadIdx.x == 0) (void)xb_add(&bar[XB_XCNT(b.x)], 1u);
    return b;
}
__device__ __forceinline__ void xcd_barrier_complete(unsigned* bar, unsigned x, unsigned& nloc, unsigned& nx) {
    const unsigned G = gridDim.x * gridDim.y * gridDim.z;
    unsigned sum, cnt, mine, sp = 0u;
    for (;;) {
        sum = 0u; cnt = 0u; mine = 0u;
#pragma unroll
        for (unsigned j = 0; j < 16; ++j) { const unsigned c = xb_ld(&bar[XB_XCNT(j)]); sum += c; cnt += (c > 0u) ? 1u : 0u; mine = (j == x) ? c : mine; }
        if (sum == G) break;
        __builtin_amdgcn_s_sleep(1);
        if ((++sp & 255u) == 0u) { if (xb_ld(&bar[XB_TMO])) break; if (sp > XB_SPIN_CAP) { atomicAdd(&bar[XB_TMO], 1u); break; } }
    }
    nloc = mine > 0u ? mine : 1u; nx = cnt > 0u ? cnt : 1u;
}

__device__ __forceinline__ void xcd_barrier(const XcdBarrier& b) {
    asm volatile("s_waitcnt vmcnt(0)" ::: "memory");
    __syncthreads();
    if (threadIdx.x == 0) {
        unsigned* bar = b.bar;
        __builtin_amdgcn_s_waitcnt(0);
        unsigned nloc = b.st[0], nx = b.st[1];
        if (nloc == 0u) { xcd_barrier_complete(bar, b.x, nloc, nx); b.st[0] = nloc; b.st[1] = nx; }
        const unsigned old = xb_add(&bar[XB_XSUB(b.x)], 1u);
        const unsigned gen = old / nloc;
        if (old + 1u == (gen + 1u) * nloc) {
            __builtin_amdgcn_fence(__ATOMIC_RELEASE, "agent");
            asm volatile("s_waitcnt vmcnt(0)" ::: "memory");
            const unsigned og = xb_add(&bar[XB_TOP], 1u);
            const unsigned tg = og / nx;
            if (og + 1u == (tg + 1u) * nx) xb_add(&bar[XB_TOPGEN], 1u);
            else XB_SPIN(xb_ld(&bar[XB_TOPGEN]) == tg, bar);
            __builtin_amdgcn_fence(__ATOMIC_ACQUIRE, "agent");
            xb_add(&bar[XB_XGEN(b.x)], 1u);
            asm volatile("s_waitcnt vmcnt(0)" ::: "memory");
        } else {
            XB_SPIN(xb_ld(&bar[XB_XGEN(b.x)]) == gen, bar);
            __builtin_amdgcn_fence(__ATOMIC_ACQUIRE, "agent");
            asm volatile("s_waitcnt vmcnt(0)" ::: "memory");
        }
    }
    __syncthreads();
}

struct Args { const float* in[24]; float* out; unsigned char* ws; int ph_lo, ph_hi; };
typedef __attribute__((address_space(4))) const unsigned char* kargp_t;
__device__ __forceinline__ const float* KIN(int k) { int z = 0; asm volatile("" : "+s"(z)); kargp_t kp = (kargp_t)__builtin_amdgcn_kernarg_segment_ptr(); return *(const float* const __attribute__((address_space(4)))*)(kp + (size_t)(k + z) * 8); }
__device__ __forceinline__ float* KOUT() { return (float*)KIN(24); }
__device__ __forceinline__ unsigned char* KWS() { return (unsigned char*)KIN(25); }
#define PH_SG int G = gridDim.x, bx = blockIdx.x; asm volatile("" : "+s"(G), "+s"(bx)); const int ngw = G * 8; (void)ngw;
#define PH_IDS PH_SG int tid = threadIdx.x; asm volatile("" : "+v"(tid)); const int lane = tid & 63, wave = __builtin_amdgcn_readfirstlane(tid >> 6); const int gw = bx * 8 + wave; (void)lane; (void)gw;
__global__ void __launch_bounds__(512, 2) mega_fwd(Args a) {
    extern __shared__ __attribute__((aligned(16))) unsigned char lds_[];
    LAS unsigned char* lds = (LAS unsigned char*)lds_;
    cg::grid_group grid = cg::this_grid();
    volatile LAS unsigned* xst = (volatile LAS unsigned*)(lds + LDS_BYTES - 64);
    if (threadIdx.x == 0) { xst[0] = 0u; xst[1] = 0u; }
    __syncthreads();
    XcdBarrier xbar = xcd_barrier_post((unsigned*)(KWS() + WS_BAR), xst);
    bool first_seam = true;
#ifndef PROBE_DUP
#define PROBE_DUP_ 0u
#else
#define PROBE_DUP_ PROBE_DUP
#endif
#ifndef MK_SPLIT
#define MK_SPLIT 0
#endif
#ifndef PH_MASK
#define PH_MASK 0xFFFFFFFFu
#endif
#if MK_SPLIT
    const int ph_lo = a.ph_lo, ph_hi = a.ph_hi; int ph = 0;
#define RUNB(b) (((PH_MASK >> (b)) & 1u) && ph >= ph_lo && ph < ph_hi)
#define SEAM() do { if (ph >= ph_lo && ph + 1 < ph_hi) grid.sync(); ++ph; } while (0)
#else
    (void)a;
#define RUNB(b) ((PH_MASK >> (b)) & 1u)
#define SEAM() do { if (first_seam) { grid.sync(); first_seam = false; } else xcd_barrier(xbar); if ((PROBE_DUP_ >> 10) & 1u) xcd_barrier(xbar); } while (0)
#endif
#define RUN() RUNB(1)
#ifndef PROBE_DUP
#define PROBE_DUP 0u
#endif
#define REP(k) for (int rep_ = 0; rep_ < (((PROBE_DUP >> (k)) & 1u) ? 2 : 1); ++rep_)
#define WSP(off) ((bf16_t*)(KWS() + (off)))

    if (RUNB(0)) REP(3) { PH_IDS
        unsigned char* ws = KWS();
        for (int task = bx; task < 768; task += G) mod_task(task, KIN(2), KIN(6), KIN(7), KIN(8), (float*)(ws + WS_MOD), lds, tid, wave, lane);
        if (bx == G - 1) { float* lbt = (float*)(ws + WS_LB); float* ropet = (float*)(ws + WS_ROPE); const float* lg = KIN(12);
            for (int i = tid; i < 2 * DM; i += 512) { const int d = i / DM, c = i % DM; const float l0 = lg[(d * 2 + 0) * DM + c], l1 = lg[(d * 2 + 1) * DM + c]; lbt[i] = 1.f / (1.f + expf(l1 - l0)); }
            for (int i = tid; i < 2048; i += 512) { const int pos = i >> 5, f = i & 31; const float inv = powf(10000.f, -(float)f / 32.f); const float ang = (float)pos * inv; ropet[2 * i] = cosf(ang); ropet[2 * i + 1] = sinf(ang); }
        }
    }
    SEAM();
    for (int l = 0; l < 2; ++l) {
        if (RUN()) REP(4) { PH_IDS
            unsigned char* ws = KWS(); const float* modl = (const float*)(ws + WS_MOD) + (size_t)l * 9 * NMOD; float* out = KOUT();
            if (l == 0) norm_pass(KIN(0), KIN(1), KIN(9), modl, 0, 1, (bf16_t*)(ws + WS_H), gw, ngw, lane);
            else norm_pass(out, out + (size_t)NPR * DM, KIN(9) + DM, modl, 0, 1, (bf16_t*)(ws + WS_H), gw, ngw, lane);
            transpose_layer(l, ws, lds, gw, ngw, wave, lane);
            if (l == 1) cache_convert(KIN(4), KIN(5), (bf16_t*)(ws + WS_B0) + SZ / 2, (bf16_t*)(ws + WS_B0) + SZ, gw, ngw, lane);
        }
        SEAM();
        if (l == 0) {
            if (RUNB(2)) REP(0) { PH_SG unsigned char* ws = KWS(); pg8::Gemm g{(bf16_t*)(ws + WS_H), (bf16_t*)(ws + WS_WIN), MTOT, 10240, DM}; pg8::StaticOrder S; S.init(MTOT, 10240, G, bx);
                EpiHgrnIn E{(bf16_t*)(ws + WS_B0), (const float*)(ws + WS_LB)};
                pg8::gemm_phase<EpiHgrnIn, pg8::StaticOrder, true, true>(lds, g, S, E); }
            SEAM();
            if (RUNB(3)) REP(1) { PH_IDS
                for (int u = bx; u < 768; u += G) {
                    bf16_t* B0 = WSP(WS_B0); float* out = KOUT();
                    int b, h, dir, seqbase, nch; const float* S0 = nullptr; float* So = nullptr;
                    if (u < 256) { b = u >> 5; h = (u >> 1) & 15; dir = u & 1; seqbase = NPR + b * 4096; nch = 64; S0 = KIN(3) + ((size_t)(b * 2 + dir) * 16 + h) * 16384; }
                    else { const int p = u - 256; b = p >> 5; h = (p >> 1) & 15; dir = p & 1; seqbase = b * 256; nch = 4; So = out + OUT_STATE + ((size_t)(b * 2 + dir) * 16 + h) * 16384; }
                    hgrn_unit(lds, B0, B0 + 3 * (SZ / 2), B0 + (size_t)(1 + dir) * (SZ / 2), (bf16_t*)out + (size_t)dir * MTOT * DM, S0, So, seqbase, nch, h, dir, tid, wave, lane);
                }
            }
            SEAM();
            if (RUN()) REP(7) { PH_IDS bf16_t* B0 = WSP(WS_B0); float* out = KOUT(); hgrn_combine((bf16_t*)out, (bf16_t*)out + (size_t)MTOT * DM, B0 + 2 * SZ, KIN(13), WSP(WS_H), gw, ngw, lane); }
            SEAM();
            if (RUNB(4)) { PH_SG unsigned char* ws = KWS(); pg8::Gemm g{(bf16_t*)(ws + WS_H), (bf16_t*)(ws + WS_WOUT), MTOT, DM, DM}; pg8::StaticOrder S; S.init(MTOT, DM, G, bx);
                EpiResid E{KIN(0), KIN(1), KOUT(), (const float*)(ws + WS_MOD) + 2 * DM};
                pg8::gemm_phase<EpiResid, pg8::StaticOrder, true, true>(lds, g, S, E); }
            SEAM();
        } else {
            if (RUNB(5)) REP(6) { PH_SG unsigned char* ws = KWS(); bf16_t* B0 = (bf16_t*)(ws + WS_B0); float* out = KOUT();
                pg8::Gemm g{(bf16_t*)(ws + WS_H), (bf16_t*)(ws + WS_WIN), MTOT, 6144, DM}; pg8::StaticOrder S; S.init(MTOT, 6144, G, bx);
                EpiAttnIn E{B0, B0 + SZ / 2, B0 + SZ, B0 + 3 * (SZ / 2), B0 + 3 * (SZ / 2) + (size_t)NPR * DM, out + OUT_NK, out + OUT_NV, (const float*)(ws + WS_ROPE)};
                pg8::gemm_phase<EpiAttnIn, pg8::StaticOrder, true, true>(lds, g, S, E); }
            SEAM();
            if (RUNB(6)) REP(2) { PH_SG
                const int vcu = (G % 8 == 0) ? (bx % 8) * (G / 8) + bx / 8 : bx;
                for (int uu = vcu; uu < 4608; uu += G) {
                    bf16_t* B0 = WSP(WS_B0); bf16_t *Qa = B0, *KA = B0 + SZ / 2, *VA = B0 + SZ, *KP = B0 + 3 * (SZ / 2), *VP = KP + (size_t)NPR * DM, *O4 = VP + (size_t)NPR * DM;
                    const att::bf16 *qp, *kp, *vp; att::bf16* op; int seq;
                    if (uu < 4096) { const int qb = uu & 15, half = (uu >> 4) & 1, j = (uu >> 5) & 15, b = uu >> 9; const size_t row = NPR + (size_t)b * 4096 + qb * 256;
                        qp = (const att::bf16*)(Qa + row * DM + j * 128); kp = (const att::bf16*)(KA + (size_t)b * 4608 * DM + j * 128);
                        vp = (const att::bf16*)(VA + (size_t)b * 4608 * DM + (j >> 1) * 256 + half * 128); op = (att::bf16*)(O4 + row * 4096 + (j >> 1) * 512 + (j & 1) * 256 + half * 128); seq = 4608; }
                    else { const int p = uu - 4096, half = p & 1, j = (p >> 1) & 15, b = p >> 5; const size_t row = (size_t)b * 256;
                        qp = (const att::bf16*)(Qa + row * DM + j * 128); kp = (const att::bf16*)(KP + row * DM + j * 128);
                        vp = (const att::bf16*)(VP + row * DM + (j >> 1) * 256 + half * 128); op = (att::bf16*)(O4 + row * 4096 + (j >> 1) * 512 + (j & 1) * 256 + half * 128); seq = 256; }
                    att::attn_dense_body<att::bf16>(qp, kp, vp, op, seq, (char*)lds_);
                    __syncthreads();
                }
            }
            SEAM();
            if (RUN()) REP(7) { PH_IDS bf16_t* B0 = WSP(WS_B0); attn_combine(B0 + 3 * (SZ / 2) + 2 * (size_t)NPR * DM, KIN(16), KIN(17), WSP(WS_H), gw, ngw, lane); }
            SEAM();
            if (RUNB(4)) { PH_SG unsigned char* ws = KWS(); float* out = KOUT(); pg8::Gemm g{(bf16_t*)(ws + WS_H), (bf16_t*)(ws + WS_WOUT), MTOT, DM, DM}; pg8::StaticOrder S; S.init(MTOT, DM, G, bx);
                EpiResid E{out, out + (size_t)NPR * DM, out, (const float*)(ws + WS_MOD) + 9 * NMOD + 2 * DM};
                pg8::gemm_phase<EpiResid, pg8::StaticOrder, true, true>(lds, g, S, E); }
            SEAM();
        }
        if (RUN()) REP(4) { PH_IDS unsigned char* ws = KWS(); float* out = KOUT(); norm_pass(out, out + (size_t)NPR * DM, KIN(10) + l * DM, (const float*)(ws + WS_MOD) + (size_t)l * 9 * NMOD, 3, 4, (bf16_t*)(ws + WS_H), gw, ngw, lane); }
        SEAM();
        if (RUNB(7)) REP(5) { PH_SG unsigned char* ws = KWS(); bf16_t* B0 = (bf16_t*)(ws + WS_B0);
            pg8::Gemm g{(bf16_t*)(ws + WS_H), (bf16_t*)(ws + WS_WUP), MTOT, NUP, DM}; pg8::StaticOrder S; S.init(MTOT, NUP, G, bx);
            EpiFfnUp E{B0, B0 + (size_t)MTOT * DFF, KIN(20) + (size_t)l * 3 * NUP, KIN(21) + (size_t)l * NUP};
            pg8::gemm_phase<EpiFfnUp, pg8::StaticOrder, true, true>(lds, g, S, E); }
        SEAM();
        if (RUN()) REP(8) { PH_IDS bf16_t* B0 = WSP(WS_B0); ffn_fixup(B0 + (size_t)MTOT * DFF, KIN(20) + (size_t)l * 3 * NUP, KIN(21) + (size_t)l * NUP, B0, gw, ngw, lane); }
        SEAM();
        if (RUNB(4)) { PH_SG unsigned char* ws = KWS(); float* out = KOUT(); pg8::Gemm g{(bf16_t*)(ws + WS_B0), (bf16_t*)(ws + WS_WDOWN), MTOT, DM, DFF}; pg8::StaticOrder S; S.init(MTOT, DM, G, bx);
            EpiResid E{out, out + (size_t)NPR * DM, out, (const float*)(ws + WS_MOD) + (size_t)l * 9 * NMOD + 5 * DM};
            pg8::gemm_phase<EpiResid, pg8::StaticOrder, true, true>(lds, g, S, E); }
        SEAM();
    }
    if ((PROBE_DUP >> 12) & 1u) { PH_IDS final_norm(KOUT(), KIN(23), gw, ngw, lane, (float*)(KWS() + WS_B0)); }
    if (RUN()) { PH_IDS final_norm(KOUT(), KIN(23), gw, ngw, lane); }
#undef RUN
#undef RUNB
#undef SEAM
}

constexpr int N_PHASES = 21;
extern "C" void kernel_launch(void* const* d_in, const int* in_sizes, int n_in, void* d_out, int out_size, void* d_ws, size_t ws_size, hipStream_t stream) {
    static int grid = 0;
    if (grid == 0) {
        if (n_in != 24 || ws_size < WS_END) { fprintf(stderr, "kernel_launch: unexpected n_in %d or ws_size %zu (< %zu)\n", n_in, ws_size, (size_t)WS_END); grid = -1; return; }
        int dev = 0, cus = 0, per_cu = 0;
        hipGetDevice(&dev); hipDeviceGetAttribute(&cus, hipDeviceAttributeMultiprocessorCount, dev);
        if (hipFuncSetAttribute((const void*)mega_fwd, hipFuncAttributeMaxDynamicSharedMemorySize, LDS_BYTES) != hipSuccess) { fprintf(stderr, "kernel_launch: hipFuncSetAttribute failed\n"); grid = -1; return; }
        if (hipOccupancyMaxActiveBlocksPerMultiprocessor(&per_cu, (const void*)mega_fwd, 512, LDS_BYTES) != hipSuccess || per_cu < 1) { fprintf(stderr, "kernel_launch: occupancy query says %d\n", per_cu); per_cu = 1; }
        (void)hipGetLastError();
        grid = cus * (per_cu > 1 ? 1 : per_cu);
        if (grid <= 0) grid = 256;
    }
    if (grid < 0) return;
    if (hipMemsetAsync((char*)d_ws, 0, WS_BAR + BAR_BYTES, stream) != hipSuccess) { fprintf(stderr, "kernel_launch: memset failed\n"); return; }
    Args a{};
    for (int i = 0; i < 24; ++i) a.in[i] = (const float*)d_in[i];
    a.out = (float*)d_out; a.ws = (unsigned char*)d_ws;
#if MK_SPLIT
    for (int p = 0; p < N_PHASES; ++p) { a.ph_lo = p; a.ph_hi = p + 1; void* args[] = {&a};
        hipError_t e = hipLaunchCooperativeKernel((const void*)mega_fwd, dim3(grid), dim3(512), args, LDS_BYTES, stream);
        if (e != hipSuccess) { fprintf(stderr, "launch %d failed: %s\n", p, hipGetErrorString(e)); break; } }
#else
    a.ph_lo = 0; a.ph_hi = N_PHASES;
    void* args[] = {&a};
    hipError_t e = hipLaunchCooperativeKernel((const void*)mega_fwd, dim3(grid), dim3(512), args, LDS_BYTES, stream);
    if (e != hipSuccess) fprintf(stderr, "cooperative launch failed: %s (grid %d)\n", hipGetErrorString(e), grid);
#endif
}
```
